# Optimizing an MI355X kernel written in HIP

```python
import math
import jax, jax.numpy as jnp
from jax import lax
import numpy as np

D_MODEL = 1024
BATCH = 8
SEQ = 2048
DEPTH = 1

GRID_W = 64
CTX_LEN = 256
HEAD_DIM = 64
MIX_WIDTH = D_MODEL
DIFF_HEADS = (MIX_WIDTH // 2) // (2 * HEAD_DIM)
NA_HEADS = (MIX_WIDTH // 2) // HEAD_DIM
DIFF_WIDTH = DIFF_HEADS * 2 * HEAD_DIM
NA_WIDTH = NA_HEADS * HEAD_DIM
IN_WIDTH = 3 * DIFF_WIDTH + 3 * NA_WIDTH
NA_KH_MAX = 8
NA_KW = 16
NA_QCOL_BLOCK = 16
NA_KCOL_BAND = 32
D_FF = 2816
ROPE_BASE = 10000.0
NORM_EPS = 1e-6
Q_BLOCK = 128
N_MOD = 9
NEG_INF = -1e30

kernel_name = "hybrid_diffattn_natten_macaron_dit"


def rms_norm(x, g):
    xf = x.astype(jnp.float32)
    y = xf * lax.rsqrt(jnp.mean(xf * xf, axis=-1, keepdims=True) + NORM_EPS)
    return (y * g.astype(jnp.float32)).astype(x.dtype)


def modulate(h, shift, scale):
    return h * (1.0 + scale) + shift


def adaln(cond, w_ada, b_ada):
    return jax.nn.silu(cond) @ w_ada + b_ada


def swiglu(h, w_gu, w_down):
    g, u = jnp.split(h @ w_gu, 2, axis=-1)
    return (jax.nn.silu(g) * u) @ w_down


def ffn_half_step(h, g, shift, scale, gate, w_gu, w_down):
    return h + 0.5 * gate * swiglu(modulate(rms_norm(h, g), shift, scale), w_gu, w_down)


def axial_rope_angles(n_tokens):
    t = jnp.arange(n_tokens, dtype=jnp.int32)
    row = (t // GRID_W).astype(jnp.float32)
    col = (t % GRID_W).astype(jnp.float32)
    n_freq = HEAD_DIM // 4
    inv_freq = ROPE_BASE ** (-jnp.arange(n_freq, dtype=jnp.float32) / n_freq)
    return row[:, None] * inv_freq, col[:, None] * inv_freq


def rope_rotate(x, ang):
    x1, x2 = jnp.split(x, 2, axis=-1)
    cos = jnp.cos(ang).astype(x.dtype)
    sin = jnp.sin(ang).astype(x.dtype)
    return jnp.concatenate([x1 * cos - x2 * sin, x2 * cos + x1 * sin], axis=-1)


def apply_axial_rope(x, ang_row, ang_col):
    xr, xc = jnp.split(x, 2, axis=-1)
    return jnp.concatenate([rope_rotate(xr, ang_row), rope_rotate(xc, ang_col)], axis=-1)


def split_heads(t, n_heads, hd):
    B, T, _ = t.shape
    return t.reshape(B, T, n_heads, hd).transpose(0, 2, 1, 3)


def merge_heads(t):
    B, H, T, e = t.shape
    return t.transpose(0, 2, 1, 3).reshape(B, T, H * e)


def diff_heads_qk(t, gain):
    B, T, _ = t.shape
    t = t.reshape(B, T, DIFF_HEADS, 2, HEAD_DIM).transpose(0, 2, 3, 1, 4)
    return rms_norm(t, gain)


def diff_lambda(lq1, lk1, lq2, lk2, lam_init):
    f = lambda a, b: jnp.exp(jnp.sum(a.astype(jnp.float32) * b.astype(jnp.float32)))
    return f(lq1, lk1) - f(lq2, lk2) + lam_init


def diff_core(q, k, v, lam):
    s = jnp.einsum('bhcqd,bhckd->bhcqk', q, k).astype(jnp.float32) * (HEAD_DIM ** -0.5)
    p = jax.nn.softmax(s, axis=-1)
    p = p[:, :, 0] - lam * p[:, :, 1]
    return jnp.einsum('bhqk,bhke->bhqe', p.astype(v.dtype), v)


def diff_attention_blocks(q, k, v, lam):
    B, H, _, S, d = q.shape
    nb = S // Q_BLOCK
    qb = jnp.moveaxis(q.reshape(B, H, 2, nb, Q_BLOCK, d), 3, 0)
    out = lax.map(lambda qq: diff_core(qq, k, v, lam), qb)
    return jnp.moveaxis(out, 0, 2).reshape(B, H, S, v.shape[-1])


def dense_attention(q, k, v):
    s = jnp.einsum('bhqd,bhkd->bhqk', q, k).astype(jnp.float32) * (HEAD_DIM ** -0.5)
    p = jax.nn.softmax(s, axis=-1)
    return jnp.einsum('bhqk,bhkd->bhqd', p.astype(v.dtype), v)


def na_column_tables():
    n_cb = GRID_W // NA_QCOL_BLOCK
    qcol = np.arange(GRID_W).reshape(n_cb, NA_QCOL_BLOCK)
    cs = np.clip(qcol - NA_KW // 2, 0, GRID_W - NA_KW)
    bs = np.clip(np.arange(n_cb) * NA_QCOL_BLOCK - NA_KW // 2, 0, GRID_W - NA_KCOL_BAND)
    kcol = bs[:, None] + np.arange(NA_KCOL_BAND)
    valid = (kcol[:, None, :] >= cs[:, :, None]) & (kcol[:, None, :] < cs[:, :, None] + NA_KW)
    col_off = np.clip(kcol[:, None, :] - qcol[:, :, None] + NA_KW - 1, 0, 2 * NA_KW - 2)
    return kcol.astype(np.int32), valid, col_off.astype(np.int32)


def neighborhood_attention(q, k, v, k_ctx, v_ctx, rpb):
    B, H, S, d = q.shape
    rows = S // GRID_W
    kh = min(NA_KH_MAX, rows)
    n_cb = GRID_W // NA_QCOL_BLOCK
    kcol, valid, col_off = na_column_tables()
    qg = q.reshape(B, H, rows, GRID_W, d)
    kg = k.reshape(B, H, rows, GRID_W, d)
    vg = v.reshape(B, H, rows, GRID_W, d)
    rpb_col = jnp.take(rpb, col_off, axis=2).astype(jnp.float32)
    scale = HEAD_DIM ** -0.5
    n_win = kh * NA_KCOL_BAND

    def row_step(r):
        rs = jnp.clip(r - kh // 2, 0, rows - kh)
        k_rows = lax.dynamic_slice_in_dim(kg, rs, kh, axis=2)
        v_rows = lax.dynamic_slice_in_dim(vg, rs, kh, axis=2)
        k_win = jnp.take(k_rows, kcol, axis=3)
        v_win = jnp.take(v_rows, kcol, axis=3)
        q_r = lax.dynamic_index_in_dim(qg, r, axis=2, keepdims=False).reshape(B, H, n_cb, NA_QCOL_BLOCK, d)
        s_win = jnp.einsum('bhnqd,bhinkd->bhnqik', q_r, k_win).astype(jnp.float32) * scale
        row_idx = rs + jnp.arange(kh, dtype=jnp.int32) - r + (NA_KH_MAX - 1)
        bias = jnp.take(rpb_col, row_idx, axis=1).transpose(0, 2, 3, 1, 4)
        s_win = jnp.where(valid[:, :, None, :], s_win + bias[None], NEG_INF)
        s_ctx = jnp.einsum('bhnqd,bhcd->bhnqc', q_r, k_ctx).astype(jnp.float32) * scale
        s = jnp.concatenate([s_win.reshape(B, H, n_cb, NA_QCOL_BLOCK, n_win), s_ctx], axis=-1)
        p = jax.nn.softmax(s, axis=-1).astype(v.dtype)
        p_win = p[..., :n_win].reshape(B, H, n_cb, NA_QCOL_BLOCK, kh, NA_KCOL_BAND)
        p_ctx = p[..., n_win:]
        out = (jnp.einsum('bhnqik,bhinkd->bhnqd', p_win, v_win)
               + jnp.einsum('bhnqc,bhcd->bhnqd', p_ctx, v_ctx))
        return out.reshape(B, H, GRID_W, d)

    out = lax.map(row_step, jnp.arange(rows, dtype=jnp.int32))
    return out.transpose(1, 2, 0, 3, 4).reshape(B, H, S, d)


def setup_inputs(seed: int = 0) -> dict:
    key = jax.random.key(seed)
    ks = jax.random.split(key, 32)
    L, D = DEPTH, D_MODEL
    nrm = lambda k, shape, s: jax.random.normal(k, shape, jnp.float32) * s
    gain = lambda k, shape: 1.0 + 0.02 * jax.random.normal(k, shape, jnp.float32)
    return {
        "x": nrm(ks[0], (BATCH, SEQ, D), 1.0),
        "c": nrm(ks[1], (BATCH, D), 1.0),
        "ctx": nrm(ks[2], (BATCH, CTX_LEN, D), 1.0),
        "c_ctx": nrm(ks[3], (D,), 1.0),
        "w_ada": nrm(ks[4], (L, D, N_MOD * D), 0.5 * D ** -0.5),
        "b_ada": nrm(ks[5], (L, N_MOD * D), 0.01),
        "norm1": gain(ks[6], (L, D)),
        "norm2": gain(ks[7], (L, D)),
        "norm3": gain(ks[8], (L, D)),
        "ffn1_w_gu": nrm(ks[9], (L, D, 2 * D_FF), D ** -0.5),
        "ffn1_w_down": nrm(ks[10], (L, D_FF, D), D_FF ** -0.5),
        "w_in": nrm(ks[11], (L, D, IN_WIDTH), D ** -0.5),
        "diff_q_norm": gain(ks[12], (L, HEAD_DIM)),
        "diff_k_norm": gain(ks[13], (L, HEAD_DIM)),
        "lam_q1": nrm(ks[14], (L, HEAD_DIM), 0.1),
        "lam_k1": nrm(ks[15], (L, HEAD_DIM), 0.1),
        "lam_q2": nrm(ks[16], (L, HEAD_DIM), 0.1),
        "lam_k2": nrm(ks[17], (L, HEAD_DIM), 0.1),
        "diff_out_norm": gain(ks[18], (L, 2 * HEAD_DIM)),
        "na_q_norm": gain(ks[19], (L, HEAD_DIM)),
        "na_k_norm": gain(ks[20], (L, HEAD_DIM)),
        "na_rpb": nrm(ks[21], (L, NA_HEADS, 2 * NA_KH_MAX - 1, 2 * NA_KW - 1), 0.1),
        "w_out": nrm(ks[22], (L, MIX_WIDTH, D), MIX_WIDTH ** -0.5),
        "ffn2_w_gu": nrm(ks[23], (L, D, 2 * D_FF), D ** -0.5),
        "ffn2_w_down": nrm(ks[24], (L, D_FF, D), D_FF ** -0.5),
    }


def reference(x, c, ctx, c_ctx, w_ada, b_ada, norm1, norm2, norm3, ffn1_w_gu, ffn1_w_down, w_in,
              diff_q_norm, diff_k_norm, lam_q1, lam_k1, lam_q2, lam_k2, diff_out_norm,
              na_q_norm, na_k_norm, na_rpb, w_out, ffn2_w_gu, ffn2_w_down):
    S = x.shape[1]
    ang_row, ang_col = axial_rope_angles(S)
    splits = (DIFF_WIDTH, 2 * DIFF_WIDTH, 3 * DIFF_WIDTH, 3 * DIFF_WIDTH + NA_WIDTH, 3 * DIFF_WIDTH + 2 * NA_WIDTH)
    h, hc = x, ctx
    for l in range(DEPTH):
        update_ctx = l < DEPTH - 1
        lam_init = 0.8 - 0.6 * math.exp(-0.3 * l)
        mod = jnp.split(adaln(c, w_ada[l], b_ada[l])[:, None, :], N_MOD, axis=-1)
        mod_c = jnp.split(adaln(c_ctx, w_ada[l], b_ada[l]), N_MOD, axis=-1)

        h = ffn_half_step(h, norm1[l], mod[0], mod[1], mod[2], ffn1_w_gu[l], ffn1_w_down[l])
        hc = ffn_half_step(hc, norm1[l], mod_c[0], mod_c[1], mod_c[2], ffn1_w_gu[l], ffn1_w_down[l])

        y = modulate(rms_norm(h, norm2[l]), mod[3], mod[4]) @ w_in[l]
        yc = modulate(rms_norm(hc, norm2[l]), mod_c[3], mod_c[4]) @ w_in[l]
        dq, dk, dv, nq, nk, nv = jnp.split(y, splits, axis=-1)
        dq_c, dk_c, dv_c, nq_c, nk_c, nv_c = jnp.split(yc, splits, axis=-1)

        lam = diff_lambda(lam_q1[l], lam_k1[l], lam_q2[l], lam_k2[l], lam_init)
        a_q = apply_axial_rope(diff_heads_qk(dq, diff_q_norm[l]), ang_row, ang_col)
        a_k = apply_axial_rope(diff_heads_qk(dk, diff_k_norm[l]), ang_row, ang_col)
        a_v = split_heads(dv, DIFF_HEADS, 2 * HEAD_DIM)
        a_k_c = diff_heads_qk(dk_c, diff_k_norm[l])
        a_v_c = split_heads(dv_c, DIFF_HEADS, 2 * HEAD_DIM)
        k_all = jnp.concatenate([a_k_c, a_k], axis=3)
        v_all = jnp.concatenate([a_v_c, a_v], axis=2)
        o_a = diff_attention_blocks(a_q, k_all, v_all, lam)
        o_a = merge_heads(rms_norm(o_a, diff_out_norm[l]) * (1.0 - lam_init))

        b_q = rms_norm(split_heads(nq, NA_HEADS, HEAD_DIM), na_q_norm[l])
        b_k = rms_norm(split_heads(nk, NA_HEADS, HEAD_DIM), na_k_norm[l])
        b_v = split_heads(nv, NA_HEADS, HEAD_DIM)
        b_k_c = rms_norm(split_heads(nk_c, NA_HEADS, HEAD_DIM), na_k_norm[l])
        b_v_c = split_heads(nv_c, NA_HEADS, HEAD_DIM)
        o_b = merge_heads(neighborhood_attention(b_q, b_k, b_v, b_k_c, b_v_c, na_rpb[l]))

        h = h + mod[5] * (jnp.concatenate([o_a, o_b], axis=-1) @ w_out[l])
        h = ffn_half_step(h, norm3[l], mod[6], mod[7], mod[8], ffn2_w_gu[l], ffn2_w_down[l])

        if update_ctx:
            oc_a = diff_core(diff_heads_qk(dq_c, diff_q_norm[l]), a_k_c, a_v_c, lam)
            oc_a = merge_heads(rms_norm(oc_a, diff_out_norm[l]) * (1.0 - lam_init))
            oc_b = merge_heads(dense_attention(rms_norm(split_heads(nq_c, NA_HEADS, HEAD_DIM), na_q_norm[l]), b_k_c, b_v_c))
            hc = hc + mod_c[5] * (jnp.concatenate([oc_a, oc_b], axis=-1) @ w_out[l])
            hc = ffn_half_step(hc, norm3[l], mod_c[6], mod_c[7], mod_c[8], ffn2_w_gu[l], ffn2_w_down[l])
    return h
```

```cpp
#include <hip/hip_runtime.h>
#include <cstdio>
#include <cstdint>

typedef unsigned short bf16_t;
__device__ __forceinline__ float bf2f(bf16_t v) { return __uint_as_float((unsigned)v << 16); }
__device__ __forceinline__ bf16_t f2bf(float f) { unsigned u = __float_as_uint(f); return (bf16_t)((u + 0x7fffu + ((u >> 16) & 1u)) >> 16); }

constexpr int D = 1024, NB = 8, SEQ = 2048, CTX = 256, FF = 2816, NIN = 3072, NMOD = 9;
constexpr int ML = NB * SEQ;
constexpr int MC = NB * CTX;
constexpr int MA = ML + MC;
constexpr float EPS = 1e-6f;
constexpr float LOG2E = 1.4426950408889634f;
constexpr float C2 = 0.125f * LOG2E;
constexpr float LAM_INIT = 0.2f;

constexpr size_t MiB = 1u << 20;
constexpr size_t WS_CTL = 0;
constexpr size_t WS_MOD = 1 * MiB;
constexpr size_t WS_MISC = 1 * MiB + 512 * 1024;
constexpr size_t WS_XN = 43 * MiB;
constexpr size_t WS_H1C = 79 * MiB;
constexpr size_t WS_BIG = 87 * MiB;
constexpr size_t WS_OD = WS_BIG + (size_t)MA * NIN * 2;
constexpr size_t WS_END = WS_OD + (size_t)ML * D * 2;
static_assert(WS_END <= 256 * MiB, "workspace");

__global__ void __launch_bounds__(256) k_adaln(const float* __restrict__ c, const float* __restrict__ c_ctx, const float* __restrict__ w_ada, const float* __restrict__ b_ada, float* __restrict__ mod) {
    __shared__ float s[D];
    const int r = blockIdx.y, n = blockIdx.x * 256 + threadIdx.x;
    const float* cond = r < NB ? c + r * D : c_ctx;
    for (int k = threadIdx.x; k < D; k += 256) { const float v = cond[k]; s[k] = v / (1.f + expf(-v)); }
    __syncthreads();
    float acc = 0.f;
    for (int k = 0; k < D; ++k) acc += s[k] * w_ada[(size_t)k * (NMOD * D) + n];
    mod[r * (NMOD * D) + n] = acc + b_ada[n];
}
__global__ void k_misc(const float* lq1, const float* lk1, const float* lq2, const float* lk2, float* misc) {
    const int tid = threadIdx.x;
    const int pos = tid >> 4, i = tid & 15;
    const float inv_freq = powf(10000.f, -(float)i / 16.f);
    const float ang = (float)pos * inv_freq;
    misc[pos * 16 + i] = cosf(ang);
    misc[1024 + pos * 16 + i] = sinf(ang);
    if (tid == 0) {
        float a = 0.f, b = 0.f;
        for (int d = 0; d < 64; ++d) { a += lq1[d] * lk1[d]; b += lq2[d] * lk2[d]; }
        misc[2048] = expf(a) - expf(b) + LAM_INIT;
    }
}

__global__ void __launch_bounds__(256) k_normmod(const float* __restrict__ lat, const float* __restrict__ ctx, int nrows, const float* __restrict__ gain, const float* __restrict__ mod, int shift_i, int scale_i, bf16_t* __restrict__ XN) {
    const int row = blockIdx.x * 4 + (threadIdx.x >> 6), lane = threadIdx.x & 63;
    if (row >= nrows) return;
    const float* src = row < ML ? lat + (size_t)row * D : ctx + (size_t)(row - ML) * D;
    const int b = row < ML ? row / SEQ : NB;
    const float* sh = mod + b * (NMOD * D) + shift_i * D; const float* sc = mod + b * (NMOD * D) + scale_i * D;
    float4 v[4]; float ss = 0.f;
    for (int j = 0; j < 4; ++j) { v[j] = *(const float4*)(src + j * 256 + lane * 4); ss += v[j].x * v[j].x + v[j].y * v[j].y + v[j].z * v[j].z + v[j].w * v[j].w; }
    for (int o = 1; o < 64; o <<= 1) ss += __shfl_xor(ss, o);
    const float rstd = rsqrtf(ss * (1.f / D) + EPS);
    for (int j = 0; j < 4; ++j) {
        const int col = j * 256 + lane * 4;
        const float4 g = *(const float4*)(gain + col), s4 = *(const float4*)(sh + col), c4 = *(const float4*)(sc + col);
        ushort4 o;
        o.x = f2bf(v[j].x * rstd * g.x * (1.f + c4.x) + s4.x); o.y = f2bf(v[j].y * rstd * g.y * (1.f + c4.y) + s4.y);
        o.z = f2bf(v[j].z * rstd * g.z * (1.f + c4.z) + s4.z); o.w = f2bf(v[j].w * rstd * g.w * (1.f + c4.w) + s4.w);
        *(ushort4*)(XN + (size_t)row * D + col) = o;
    }
}

struct SlowEpi {
    bf16_t* out_bf; int ldo;
    const float* base_lat; const float* base_ctx; float* out_lat; float* out_ctx; const float* mod; int mod_i; float coef;
};
template <int MODE>
__global__ void __launch_bounds__(256) k_gemm_slow(const bf16_t* __restrict__ A, int lda, const float* __restrict__ W, int ldw, int K, SlowEpi E) {
    __shared__ float As[16][68];
    __shared__ float Bs[16][64];
    __shared__ float Bs2[16][64];
    const int tid = threadIdx.x, m0 = blockIdx.y * 64, n0 = blockIdx.x * 64, ty = tid >> 4, tx = tid & 15;
    float acc[4][4] = {}, acc2[4][4] = {};
    for (int k0 = 0; k0 < K; k0 += 16) {
        { const int r = tid >> 2, kc = (tid & 3) * 4; const ushort4 a = *(const ushort4*)(A + (size_t)(m0 + r) * lda + k0 + kc);
          As[kc + 0][r] = bf2f(a.x); As[kc + 1][r] = bf2f(a.y); As[kc + 2][r] = bf2f(a.z); As[kc + 3][r] = bf2f(a.w); }
        { const int kr = tid >> 4, nc = (tid & 15) * 4; *(float4*)&Bs[kr][nc] = *(const float4*)(W + (size_t)(k0 + kr) * ldw + n0 + nc);
          if (MODE == 0) *(float4*)&Bs2[kr][nc] = *(const float4*)(W + (size_t)(k0 + kr) * ldw + FF + n0 + nc); }
        __syncthreads();
#pragma unroll
        for (int k = 0; k < 16; ++k) {
            const float4 a = *(const float4*)&As[k][ty * 4], b = *(const float4*)&Bs[k][tx * 4];
            const float av[4] = {a.x, a.y, a.z, a.w}, bv[4] = {b.x, b.y, b.z, b.w};
#pragma unroll
            for (int i = 0; i < 4; ++i)
#pragma unroll
                for (int j = 0; j < 4; ++j) acc[i][j] += av[i] * bv[j];
            if (MODE == 0) { const float4 b2 = *(const float4*)&Bs2[k][tx * 4]; const float bw[4] = {b2.x, b2.y, b2.z, b2.w};
#pragma unroll
                for (int i = 0; i < 4; ++i)
#pragma unroll
                    for (int j = 0; j < 4; ++j) acc2[i][j] += av[i] * bw[j]; }
        }
        __syncthreads();
    }
#pragma unroll
    for (int i = 0; i < 4; ++i) {
        const int m = m0 + ty * 4 + i;
#pragma unroll
        for (int j = 0; j < 4; ++j) {
            const int n = n0 + tx * 4 + j; const float v = acc[i][j];
            if (MODE == 0) { const float g = v, u = acc2[i][j]; E.out_bf[(size_t)m * E.ldo + n] = f2bf(g / (1.f + expf(-g)) * u); }
            else if (MODE == 2) E.out_bf[(size_t)m * E.ldo + n] = f2bf(v);
            else { const bool isl = m < ML; const int b = isl ? m / SEQ : NB; const size_t off = isl ? (size_t)m * D + n : (size_t)(m - ML) * D + n;
                const float base = isl ? E.base_lat[off] : E.base_ctx[off]; const float o = base + E.coef * E.mod[b * (NMOD * D) + E.mod_i * D + n] * v;
                if (isl) E.out_lat[off] = o; else E.out_ctx[off] = o; }
        }
    }
}

__global__ void __launch_bounds__(256) k_headproc(bf16_t* __restrict__ Y, const float* __restrict__ gq, const float* __restrict__ gk, const float* __restrict__ nq, const float* __restrict__ nk, const float* __restrict__ misc) {
    const int idx = blockIdx.x * 256 + threadIdx.x; if (idx >= MA * 32) return;
    const int row = idx >> 5, g = idx & 31, grp = g >> 3, hh = g & 7;
    const int col = (grp == 0 ? 0 : grp == 1 ? 512 : grp == 2 ? 1536 : 2048) + hh * 64;
    const float* gain = grp == 0 ? gq : grp == 1 ? gk : grp == 2 ? nq : nk;
    bf16_t* p = Y + (size_t)row * NIN + col;
    float v[64]; float ss = 0.f;
#pragma unroll
    for (int d = 0; d < 64; ++d) { v[d] = bf2f(p[d]); ss += v[d] * v[d]; }
    const float rstd = rsqrtf(ss * (1.f / 64.f) + EPS);
#pragma unroll
    for (int d = 0; d < 64; ++d) v[d] = v[d] * rstd * gain[d];
    if (grp < 2 && row < ML) {
        const int t = row % SEQ, pr = t >> 6, pc = t & 63;
#pragma unroll
        for (int i = 0; i < 16; ++i) {
            const float cr = misc[pr * 16 + i], sr = misc[1024 + pr * 16 + i], cc = misc[pc * 16 + i], sc = misc[1024 + pc * 16 + i];
            const float a = v[i], b = v[i + 16]; v[i] = a * cr - b * sr; v[i + 16] = b * cr + a * sr;
            const float e = v[32 + i], f = v[48 + i]; v[32 + i] = e * cc - f * sc; v[48 + i] = f * cc + e * sc;
        }
    }
    const float sc = (grp == 0 || grp == 2) ? C2 : 1.f;
#pragma unroll
    for (int d = 0; d < 64; ++d) p[d] = f2bf(v[d] * sc);
}

__global__ void __launch_bounds__(256) k_attn_diff_slow(const bf16_t* __restrict__ Y, bf16_t* __restrict__ OD) {
    const int b = blockIdx.z, h = blockIdx.y >> 1, c = blockIdx.y & 1, q = blockIdx.x * 64 + (threadIdx.x & 63), ec = threadIdx.x >> 6;
    const bf16_t* qp = Y + (size_t)(b * SEQ + q) * NIN + h * 128 + c * 64;
    float qv[64];
#pragma unroll
    for (int d = 0; d < 64; ++d) qv[d] = bf2f(qp[d]);
    float m = -1e30f, l = 0.f, o[32];
#pragma unroll
    for (int e = 0; e < 32; ++e) o[e] = 0.f;
    for (int j = 0; j < CTX + SEQ; ++j) {
        const int row = j < CTX ? ML + b * CTX + j : b * SEQ + (j - CTX);
        const bf16_t* kp = Y + (size_t)row * NIN + 512 + h * 128 + c * 64; const bf16_t* vp = Y + (size_t)row * NIN + 1024 + h * 128 + ec * 32;
        float s = 0.f;
#pragma unroll
        for (int d = 0; d < 64; ++d) s += qv[d] * bf2f(kp[d]);
        const float mn = fmaxf(m, s), al = exp2f(m - mn), p = exp2f(s - mn);
        l = l * al + p; m = mn;
#pragma unroll
        for (int e = 0; e < 32; ++e) o[e] = o[e] * al + p * bf2f(vp[e]);
    }
    const float rl = 1.f / l;
    bf16_t* op = OD + (size_t)(b * SEQ + q) * D + h * 256 + c * 128 + ec * 32;
#pragma unroll
    for (int e = 0; e < 32; ++e) op[e] = f2bf(o[e] * rl);
}

__global__ void __launch_bounds__(256) k_attn_na_slow(const bf16_t* __restrict__ Y, const float* __restrict__ rpb, bf16_t* __restrict__ AO) {
    const int b = blockIdx.z, h = blockIdx.y, t = blockIdx.x * 128 + (threadIdx.x & 127), dc = threadIdx.x >> 7;
    const int qr = t >> 6, qc = t & 63;
    const int rs = min(max(qr - 4, 0), 24), cs = min(max(qc - 8, 0), 48);
    const bf16_t* qp = Y + (size_t)(b * SEQ + t) * NIN + 1536 + h * 64;
    float qv[64];
#pragma unroll
    for (int d = 0; d < 64; ++d) qv[d] = bf2f(qp[d]);
    float m = -1e30f, l = 0.f, o[32];
#pragma unroll
    for (int e = 0; e < 32; ++e) o[e] = 0.f;
    for (int j = 0; j < 128 + CTX; ++j) {
        int row; float bias = 0.f;
        if (j < 128) { const int kr = rs + (j >> 4), kc = cs + (j & 15); row = b * SEQ + kr * 64 + kc; bias = rpb[(h * 15 + (kr - qr + 7)) * 31 + (kc - qc + 15)] * LOG2E; }
        else row = ML + b * CTX + (j - 128);
        const bf16_t* kp = Y + (size_t)row * NIN + 2048 + h * 64; const bf16_t* vp = Y + (size_t)row * NIN + 2560 + h * 64 + dc * 32;
        float s = bias;
#pragma unroll
        for (int d = 0; d < 64; ++d) s += qv[d] * bf2f(kp[d]);
        const float mn = fmaxf(m, s), al = exp2f(m - mn), p = exp2f(s - mn);
        l = l * al + p; m = mn;
#pragma unroll
        for (int e = 0; e < 32; ++e) o[e] = o[e] * al + p * bf2f(vp[e]);
    }
    const float rl = 1.f / l;
    bf16_t* op = AO + (size_t)(b * SEQ + t) * D + 512 + h * 64 + dc * 32;
#pragma unroll
    for (int e = 0; e < 32; ++e) op[e] = f2bf(o[e] * rl);
}

__global__ void __launch_bounds__(256) k_combine(const bf16_t* __restrict__ OD, const float* __restrict__ gain, const float* __restrict__ misc, bf16_t* __restrict__ AO) {
    const int w = blockIdx.x * 4 + (threadIdx.x >> 6), lane = threadIdx.x & 63; if (w >= ML * 4) return;
    const int row = w >> 2, h = w & 3; const float lam = misc[2048];
    const bf16_t* p0 = OD + (size_t)row * D + h * 256 + lane * 2; const bf16_t* p1 = p0 + 128;
    const float d0 = bf2f(p0[0]) - lam * bf2f(p1[0]), d1 = bf2f(p0[1]) - lam * bf2f(p1[1]);
    float ss = d0 * d0 + d1 * d1;
    for (int o = 1; o < 64; o <<= 1) ss += __shfl_xor(ss, o);
    const float rstd = rsqrtf(ss * (1.f / 128.f) + EPS) * (1.f - LAM_INIT);
    bf16_t* op = AO + (size_t)row * D + h * 128 + lane * 2;
    op[0] = f2bf(d0 * rstd * gain[lane * 2]); op[1] = f2bf(d1 * rstd * gain[lane * 2 + 1]);
}

extern "C" void kernel_launch(void* const* d_in, const int* in_sizes, int n_in, void* d_out, int out_size, void* d_ws, size_t ws_size, hipStream_t stream) {
    if (n_in != 25 || out_size != ML * D || ws_size < WS_END) { fprintf(stderr, "kernel_launch: unexpected shapes n_in %d out %d ws %zu\n", n_in, out_size, ws_size); return; }
    const float* x = (const float*)d_in[0]; const float* c = (const float*)d_in[1]; const float* ctx = (const float*)d_in[2]; const float* c_ctx = (const float*)d_in[3];
    const float* w_ada = (const float*)d_in[4]; const float* b_ada = (const float*)d_in[5];
    const float* norm1 = (const float*)d_in[6]; const float* norm2 = (const float*)d_in[7]; const float* norm3 = (const float*)d_in[8];
    const float* w_gu1 = (const float*)d_in[9]; const float* w_d1 = (const float*)d_in[10]; const float* w_in = (const float*)d_in[11];
    const float* dqn = (const float*)d_in[12]; const float* dkn = (const float*)d_in[13];
    const float* lq1 = (const float*)d_in[14]; const float* lk1 = (const float*)d_in[15]; const float* lq2 = (const float*)d_in[16]; const float* lk2 = (const float*)d_in[17];
    const float* don = (const float*)d_in[18]; const float* nqn = (const float*)d_in[19]; const float* nkn = (const float*)d_in[20]; const float* rpb = (const float*)d_in[21];
    const float* w_out = (const float*)d_in[22]; const float* w_gu2 = (const float*)d_in[23]; const float* w_d2 = (const float*)d_in[24];
    unsigned char* ws = (unsigned char*)d_ws; float* out = (float*)d_out;
    float* mod = (float*)(ws + WS_MOD); float* misc = (float*)(ws + WS_MISC);
    bf16_t* XN = (bf16_t*)(ws + WS_XN); bf16_t* AO = XN; float* H1C = (float*)(ws + WS_H1C);
    bf16_t* H = (bf16_t*)(ws + WS_BIG); bf16_t* Y = (bf16_t*)(ws + WS_BIG); bf16_t* OD = (bf16_t*)(ws + WS_OD);

    k_adaln<<<dim3(NMOD * D / 256, 9), 256, 0, stream>>>(c, c_ctx, w_ada, b_ada, mod);
    k_misc<<<1, 1024, 0, stream>>>(lq1, lk1, lq2, lk2, misc);
    k_normmod<<<MA / 4, 256, 0, stream>>>(x, ctx, MA, norm1, mod, 0, 1, XN);
    { SlowEpi E{}; E.out_bf = H; E.ldo = FF; k_gemm_slow<0><<<dim3(FF / 64, MA / 64), 256, 0, stream>>>(XN, D, w_gu1, 2 * FF, D, E); }
    { SlowEpi E{}; E.base_lat = x; E.base_ctx = ctx; E.out_lat = out; E.out_ctx = H1C; E.mod = mod; E.mod_i = 2; E.coef = 0.5f;
      k_gemm_slow<1><<<dim3(D / 64, MA / 64), 256, 0, stream>>>(H, FF, w_d1, D, FF, E); }
    k_normmod<<<MA / 4, 256, 0, stream>>>(out, H1C, MA, norm2, mod, 3, 4, XN);
    { SlowEpi E{}; E.out_bf = Y; E.ldo = NIN; k_gemm_slow<2><<<dim3(NIN / 64, MA / 64), 256, 0, stream>>>(XN, D, w_in, NIN, D, E); }
    k_headproc<<<MA * 32 / 256, 256, 0, stream>>>(Y, dqn, dkn, nqn, nkn, misc);
    k_attn_diff_slow<<<dim3(SEQ / 64, 8, NB), 256, 0, stream>>>(Y, OD);
    k_attn_na_slow<<<dim3(SEQ / 128, 8, NB), 256, 0, stream>>>(Y, rpb, AO);
    k_combine<<<ML, 256, 0, stream>>>(OD, don, misc, AO);
    { SlowEpi E{}; E.base_lat = out; E.base_ctx = out; E.out_lat = out; E.out_ctx = out; E.mod = mod; E.mod_i = 5; E.coef = 1.f;
      k_gemm_slow<1><<<dim3(D / 64, ML / 64), 256, 0, stream>>>(AO, D, w_out, D, D, E); }
    k_normmod<<<ML / 4, 256, 0, stream>>>(out, H1C, ML, norm3, mod, 6, 7, XN);
    { SlowEpi E{}; E.out_bf = H; E.ldo = FF; k_gemm_slow<0><<<dim3(FF / 64, ML / 64), 256, 0, stream>>>(XN, D, w_gu2, 2 * FF, D, E); }
    { SlowEpi E{}; E.base_lat = out; E.base_ctx = out; E.out_lat = out; E.out_ctx = out; E.mod = mod; E.mod_i = 8; E.coef = 0.5f;
      k_gemm_slow<1><<<dim3(D / 64, ML / 64), 256, 0, stream>>>(H, FF, w_d2, D, FF, E); }
}
```

```cpp
#include <hip/hip_runtime.h>
#include <hip/hip_bf16.h>
#include <cstdio>
#include <cstdint>
#include <cmath>

typedef unsigned short bf16_t;
__device__ __forceinline__ float bf2f(bf16_t v) { return __uint_as_float((unsigned)v << 16); }
__device__ __forceinline__ bf16_t f2bf(float f) { unsigned u = __float_as_uint(f); return (bf16_t)((u + 0x7fffu + ((u >> 16) & 1u)) >> 16); }

constexpr int D = 1024, NB = 8, SEQ = 2048, CTX = 256, FF = 2816, NIN = 3072, NMOD = 9;
constexpr int ML = NB * SEQ;
constexpr int MC = NB * CTX;
constexpr int MA = ML + MC;
constexpr float EPS = 1e-6f;
constexpr float LOG2E = 1.4426950408889634f;
constexpr float C2 = 0.125f * LOG2E;
constexpr float LAM_INIT = 0.2f;

constexpr size_t MiB = 1u << 20;
constexpr size_t WS_CTL = 0, CTL_ZERO_BYTES = 128 * 1024;
constexpr size_t WS_MOD = 1 * MiB;
constexpr size_t WS_MISC = 1 * MiB + 512 * 1024;
constexpr size_t WS_WGU1 = 2 * MiB, WS_WD1 = 13 * MiB, WS_WIN = 19 * MiB, WS_WOUT = 25 * MiB, WS_WGU2 = 27 * MiB, WS_WD2 = 38 * MiB;
constexpr size_t WS_XN = 44 * MiB;
constexpr size_t WS_H1C = 80 * MiB;
constexpr size_t WS_BIG = 88 * MiB;
constexpr size_t WS_OD = WS_BIG + (size_t)MA * NIN * 2;
constexpr size_t WS_PART = WS_OD + (size_t)ML * D * 2;
constexpr size_t WS_END = WS_PART + (size_t)2 * MC * D * 4;
static_assert(WS_WD2 + (size_t)D * FF * 2 <= WS_XN && WS_XN + (size_t)MA * D * 2 <= WS_H1C && WS_H1C + (size_t)MC * D * 4 <= WS_BIG && WS_END <= 256 * MiB, "workspace");

namespace pg8 {
#define PG8_LAS __attribute__((address_space(3)))
typedef unsigned short bf16_t;
typedef short bf16x8 __attribute__((ext_vector_type(8)));
typedef float f32x4 __attribute__((ext_vector_type(4)));
typedef unsigned u32x4 __attribute__((ext_vector_type(4)));
typedef unsigned u32x2 __attribute__((ext_vector_type(2)));
constexpr int BM = 256, BK = 64, HALF = 128, HTB = HALF * BK * 2  , STAGE_BYTES = 8 * HTB, NXCD = 8, WGM = 8;

__host__ __device__ __forceinline__ int lds_byte(int r, int c) { const int st = (r >> 4) * 2 + (c >> 5), rr = r & 15, cc = c & 31, ob = rr * 64 + cc * 2; return st * 1024 + (ob ^ (((ob >> 9) & 1) << 5)); }
__host__ __device__ __forceinline__ void stage_rc(int b, int& R, int& C) { const int st = b / 1024, sb = b % 1024, swz = sb ^ (((sb >> 9) & 1) << 5); R = (st >> 1) * 16 + swz / 64; C = (st & 1) * 32 + (swz % 64) / 2; }
__host__ __device__ __forceinline__ int perm32(int rho) { const int n = rho >> 4, i = rho & 15; return 8 * (i >> 2) + 4 * n + (i & 3); }

struct Unit { int pm, pn, kofs, nt; };
struct Gemm { const bf16_t* A; const bf16_t* Bt; int M, N, K; };

struct StaticOrder {
    int nM, nN, nwg, G, c;
    __host__ __device__ void init(int M, int N, int G_, int c_) { nM = M / BM; nN = N / BM; nwg = nM * nN; G = G_; c = c_; }
    __host__ __device__ bool next(int i, Unit& u) const { return at((long)i * G + c, u); }
    __host__ __device__ bool at(long L, Unit& u) const {
        if (L >= nwg) return false;
        int wgid = (int)L; { const int q = nwg / NXCD, r = nwg % NXCD, xcd = wgid % NXCD, off = wgid / NXCD; wgid = (xcd < r ? xcd * (q + 1) : r * (q + 1) + (xcd - r) * q) + off; }
        const int nig = WGM * nN, gid = wgid / nig, fm = gid * WGM, gsz = (nM - fm) < WGM ? (nM - fm) : WGM;
        u.pm = fm + ((wgid % nig) % gsz); u.pn = (wgid % nig) / gsz; u.kofs = 0; u.nt = 0; return true;
    }
    __device__ __forceinline__ void a_ready(const Unit&) const {}
    __device__ __forceinline__ void done(const Unit&) const {}
};

__device__ __forceinline__ unsigned cvt_pk_bf16(float lo, float hi) { unsigned r; asm volatile("v_cvt_pk_bf16_f32 %0, %1, %2" : "=v"(r) : "v"(lo), "v"(hi)); return r; }

struct Phase3Order {
    StaticOrder lat; int c, G;
    __host__ __device__ void init(int G_, int c_) { lat.init(ML, D, G_, c_); c = c_; G = G_; }
    __host__ __device__ bool next(int i, Unit& u) const {
        const long L = (long)i * G + c;
        if (L < ML / BM * (D / BM)) return lat.at(L, u);
        const int q = (int)(L - ML / BM * (D / BM)); if (q >= 64) return false;
        const int j = q >> 3; u.pm = ML / BM + (q & 7); u.pn = j >> 1; u.kofs = (j & 1) * (FF / 2); u.nt = FF / 2 / BK; return true;
    }
    __device__ __forceinline__ void a_ready(const Unit&) const {}
    __device__ __forceinline__ void done(const Unit&) const {}
};

#ifndef WT_STORES
#define WT_STORES 1
#endif
__device__ __forceinline__ __amdgpu_buffer_rsrc_t mk_rsrc(const void* p, size_t bytes) { return __builtin_amdgcn_make_buffer_rsrc((void*)p, (short)0, (int)bytes, 0x00020000); }
__device__ __forceinline__ void st16(__amdgpu_buffer_rsrc_t r, void* base, size_t byte_off, u32x4 v) {
    if (WT_STORES) __builtin_amdgcn_raw_buffer_store_b128(v, r, (unsigned)byte_off, 0, 16); else *(u32x4*)((char*)base + byte_off) = v; }
__device__ __forceinline__ float silu_f(float x) { return x * __builtin_amdgcn_rcpf(1.f + __builtin_amdgcn_exp2f(-x * LOG2E)); }
struct EpiGU {
    static constexpr bool PERM = false, AFTER_DRAIN = false;
    bf16_t* H; __amdgpu_buffer_rsrc_t Hr;
    __device__ __forceinline__ void operator()(const f32x4 (&acc)[2][2][4][2], const Unit& u, int wr, int wc, int fr, int fq) const {
        const int row0 = u.pm * BM + wr * 64 + fr, col0 = u.pn * HALF + wc * 32 + 8 * fq;
#pragma unroll
        for (int ai = 0; ai < 2; ++ai)
#pragma unroll
            for (int m = 0; m < 4; ++m) {
                const f32x4 g0 = acc[ai][0][m][0], g1 = acc[ai][0][m][1], u0 = acc[ai][1][m][0], u1 = acc[ai][1][m][1];
                u32x4 w;
                w.x = cvt_pk_bf16(silu_f(g0[0]) * u0[0], silu_f(g0[1]) * u0[1]); w.y = cvt_pk_bf16(silu_f(g0[2]) * u0[2], silu_f(g0[3]) * u0[3]);
                w.z = cvt_pk_bf16(silu_f(g1[0]) * u1[0], silu_f(g1[1]) * u1[1]); w.w = cvt_pk_bf16(silu_f(g1[2]) * u1[2], silu_f(g1[3]) * u1[3]);
                st16(Hr, H, ((size_t)(row0 + ai * HALF + m * 16) * FF + col0) * 2, w);
            }
    }
};
typedef _Float16 f16x4 __attribute__((ext_vector_type(4)));
template <int BT, int OT>
struct EpiRes {
    static constexpr bool PERM = false, AFTER_DRAIN = false;
    const void* base_lat; const float* base_ctx; void* out_lat; float* out_ctx; const float* mod; int mi; float coef; __amdgpu_buffer_rsrc_t pr;
    __device__ __forceinline__ void operator()(const f32x4 (&acc)[2][2][4][2], const Unit& u, int wr, int wc, int fr, int fq) const {
        const bool isl = u.pm < ML / BM; const int b = isl ? (u.pm >> 3) : NB; const int rowt = (isl ? u.pm : u.pm - ML / BM) * BM;
        const int col0 = u.pn * BM + wc * 32 + 4 * fq;
        f32x4 mv[2][2];
#pragma unroll
        for (int bj = 0; bj < 2; ++bj)
#pragma unroll
            for (int n = 0; n < 2; ++n) mv[bj][n] = *(const f32x4*)(mod + b * (NMOD * D) + mi * D + col0 + bj * HALF + n * 16) * coef;
        if (isl) {
#pragma unroll
            for (int ai = 0; ai < 2; ++ai)
#pragma unroll
                for (int m = 0; m < 4; ++m) { const size_t off = (size_t)(rowt + ai * HALF + wr * 64 + m * 16 + fr) * D + col0;
#pragma unroll
                    for (int bj = 0; bj < 2; ++bj)
#pragma unroll
                        for (int n = 0; n < 2; ++n) { const size_t o2 = off + bj * HALF + n * 16; f32x4 bs;
                            if (BT == 0) bs = *(const f32x4*)((const float*)base_lat + o2); else bs = __builtin_convertvector(*(const f16x4*)((const _Float16*)base_lat + o2), f32x4);
                            const f32x4 o = bs + mv[bj][n] * acc[ai][bj][m][n];
                            if (OT == 0) *(f32x4*)((float*)out_lat + o2) = o; else *(f16x4*)((_Float16*)out_lat + o2) = __builtin_convertvector(o, f16x4); }
                    if (BT == 1 ? (m == 3) : (m & 1)) asm volatile("" ::: "memory"); }
        } else {
            const size_t obase = ((size_t)(u.kofs ? MC : 0) * D + (size_t)rowt * D) * 4;
#pragma unroll
            for (int ai = 0; ai < 2; ++ai)
#pragma unroll
                for (int m = 0; m < 4; ++m) { const size_t off = (size_t)(ai * HALF + wr * 64 + m * 16 + fr) * D + col0;
#pragma unroll
                    for (int bj = 0; bj < 2; ++bj)
#pragma unroll
                        for (int n = 0; n < 2; ++n) st16(pr, out_ctx, obase + (off + bj * HALF + n * 16) * 4, __builtin_bit_cast(u32x4, acc[ai][bj][m][n])); }
        }
    }
};
struct EpiIn {
    static constexpr bool PERM = false, AFTER_DRAIN = false;
    bf16_t* Y; __amdgpu_buffer_rsrc_t Yr; const PG8_LAS float* tab;
    __device__ __forceinline__ void operator()(const f32x4 (&acc)[2][2][4][2], const Unit& u, int wr, int wc, int fr, int fq) const {
        const int grp = u.pn >> 1, row0 = u.pm * BM + wr * 64 + fr;
        if (grp == 2 || grp == 5) {
            const int col0 = u.pn * BM + wc * 32 + 8 * fq;
#pragma unroll
            for (int ai = 0; ai < 2; ++ai)
#pragma unroll
                for (int m = 0; m < 4; ++m) { const size_t rowo = ((size_t)(row0 + ai * HALF + m * 16) * NIN + col0) * 2;
#pragma unroll
                    for (int bj = 0; bj < 2; ++bj) { const f32x4 v0 = acc[ai][bj][m][0], v1 = acc[ai][bj][m][1]; u32x4 w;
                        w.x = cvt_pk_bf16(v0[0], v0[1]); w.y = cvt_pk_bf16(v0[2], v0[3]); w.z = cvt_pk_bf16(v1[0], v1[1]); w.w = cvt_pk_bf16(v1[2], v1[3]);
                        st16(Yr, Y, rowo + bj * HALF * 2, w); } }
        } else {
            const int hq = fq >> 1, i0 = 8 * (fq & 1);
            const PG8_LAS float* gain = tab + 2048 + 64 * (grp - (grp > 2 ? 1 : 0)) + 32 * hq + i0;
            const float sc = (grp == 0 || grp == 3) ? C2 : 1.f;
            const bool dorope = grp < 2 && u.pm < ML / BM;
            f32x4 gv[2][2];
#pragma unroll
            for (int bj = 0; bj < 2; ++bj)
#pragma unroll
                for (int n = 0; n < 2; ++n) gv[bj][n] = *(const PG8_LAS f32x4*)(gain + 16 * bj + 4 * n);
            const int col0 = u.pn * BM + wc * 64 + 32 * hq + i0;
#pragma unroll
            for (int ai = 0; ai < 2; ++ai)
#pragma unroll
                for (int m = 0; m < 4; ++m) {
                    const int row = row0 + ai * HALF + m * 16;
                    f32x4 v[2][2]; float ss = 0.f;
#pragma unroll
                    for (int bj = 0; bj < 2; ++bj)
#pragma unroll
                        for (int n = 0; n < 2; ++n) { v[bj][n] = acc[ai][bj][m][n]; const f32x4 q = v[bj][n] * v[bj][n]; ss += (q[0] + q[1]) + (q[2] + q[3]); }
                    ss += __shfl_xor(ss, 16); ss += __shfl_xor(ss, 32);
                    const float rstd = __builtin_amdgcn_rsqf(ss * (1.f / 64.f) + EPS);
#pragma unroll
                    for (int bj = 0; bj < 2; ++bj)
#pragma unroll
                        for (int n = 0; n < 2; ++n) v[bj][n] = v[bj][n] * rstd * gv[bj][n];
                    if (dorope) {
                        const int t = row & (SEQ - 1), pos = hq ? (t & 63) : (t >> 6);
#pragma unroll
                        for (int n = 0; n < 2; ++n) { const f32x4 cs = *(const PG8_LAS f32x4*)(tab + pos * 16 + i0 + 4 * n), sn = *(const PG8_LAS f32x4*)(tab + 1024 + pos * 16 + i0 + 4 * n);
                            const f32x4 a = v[0][n], b2 = v[1][n]; v[0][n] = a * cs - b2 * sn; v[1][n] = b2 * cs + a * sn; }
                    }
                    const size_t rowo = ((size_t)row * NIN + col0) * 2;
#pragma unroll
                    for (int bj = 0; bj < 2; ++bj) { const f32x4 o0 = v[bj][0] * sc, o1 = v[bj][1] * sc; u32x4 w;
                        w.x = cvt_pk_bf16(o0[0], o0[1]); w.y = cvt_pk_bf16(o0[2], o0[3]); w.z = cvt_pk_bf16(o1[0], o1[1]); w.w = cvt_pk_bf16(o1[2], o1[3]); st16(Yr, Y, rowo + 32 * bj, w); }
                }
        }
    }
};

template <class Epi, class Sched, bool ALIGN_EPI = false, bool SP2 = false>
__device__ __forceinline__ void gemm_phase(PG8_LAS unsigned char* lds, const Gemm g, const Sched& S, const Epi& E) {
    const int tid = threadIdx.x, wid = __builtin_amdgcn_readfirstlane(tid >> 6), lane = tid & 63, wr = wid >> 2, wc = wid & 3, fr = lane & 15, fq = lane >> 4;
    const int K = g.K, nt = K / BK;
    unsigned voffA[2], voffB[2];
#pragma unroll
    for (int i = 0; i < 2; ++i) { int R, C; stage_rc(tid * 16 + i * 8192, R, C); const int Rb = Epi::PERM ? ((R & ~31) + perm32(R & 31)) : R;
        voffA[i] = (unsigned)(R * K + C) * 2u; voffB[i] = (unsigned)(Rb * K + C) * 2u; }
    const size_t kstep = (size_t)(BK * 2);
    const size_t hstep = (size_t)HALF * K * 2;
    const size_t tstep = 2 * hstep;
    const unsigned ldsw = (unsigned)wid * 1024u;
    const int aoff = lds_byte(wr * 64 + fr, fq * 8), boff = lds_byte(wc * 32 + fr, fq * 8);
#define PG8_SA(b, h) (((b) * 2 + (h)) * HTB)
#define PG8_SB(b, h) ((4 + (b) * 2 + (h)) * HTB)
#define PG8_STAGE(bufoff, gbase, voff) do { _Pragma("unroll") for (int _i = 0; _i < 2; ++_i) \
        __builtin_amdgcn_global_load_lds((const unsigned*)((const char*)(gbase) + (voff)[_i]), (PG8_LAS unsigned*)(lds + (bufoff) + ldsw + _i * 8192), 16, 0, 0); } while (0)
#define PG8_LDA(dst, b, h) do { _Pragma("unroll") for (int m = 0; m < 4; ++m) _Pragma("unroll") for (int k = 0; k < 2; ++k) dst[m][k] = *(const PG8_LAS bf16x8*)(lds + PG8_SA(b, h) + aoff + m * 2048 + k * 1024); } while (0)
#define PG8_LDB(dst, b, h) do { _Pragma("unroll") for (int n = 0; n < 2; ++n) _Pragma("unroll") for (int k = 0; k < 2; ++k) dst[n][k] = *(const PG8_LAS bf16x8*)(lds + PG8_SB(b, h) + boff + n * 2048 + k * 1024); } while (0)
#define PG8_MMA(ai, bj, At, Bt) do { __builtin_amdgcn_s_setprio(1); _Pragma("unroll") for (int m = 0; m < 4; ++m) _Pragma("unroll") for (int n = 0; n < 2; ++n) _Pragma("unroll") for (int k = 0; k < 2; ++k) \
        acc[ai][bj][m][n] = __builtin_amdgcn_mfma_f32_16x16x32_bf16(Bt[n][k], At[m][k], acc[ai][bj][m][n], 0, 0, 0); __builtin_amdgcn_s_setprio(0); } while (0)
#define PG8_WAIT_V(n) asm volatile("s_waitcnt vmcnt(" #n ")" ::: "memory")
#define PG8_WAIT_L(n) asm volatile("s_waitcnt lgkmcnt(" #n ")" ::: "memory")
#define PG8_BAR __builtin_amdgcn_s_barrier()
#define PG8_SCHED __builtin_amdgcn_sched_barrier(0)
    Unit cur, nxt; int ui = 0;
    if (!S.next(0, cur)) return;
    f32x4 acc[2][2][4][2];
#pragma unroll
    for (int a = 0; a < 2; ++a)
#pragma unroll
        for (int b = 0; b < 2; ++b)
#pragma unroll
            for (int m = 0; m < 4; ++m)
#pragma unroll
                for (int n = 0; n < 2; ++n) acc[a][b][m][n] = (f32x4){0.f, 0.f, 0.f, 0.f};
    bf16x8 At[4][2], B0[2][2], B1[2][2];
    const char* cA = (const char*)g.A + (size_t)cur.pm * tstep + (size_t)cur.kofs * 2; const char* cB = (const char*)g.Bt + (size_t)cur.pn * tstep + (size_t)cur.kofs * 2;
    S.a_ready(cur);
    if constexpr (SP2) {
        PG8_STAGE(PG8_SB(0, 0), cB, voffB); PG8_STAGE(PG8_SB(0, 1), cB + hstep, voffB); PG8_STAGE(PG8_SA(0, 0), cA, voffA); PG8_STAGE(PG8_SA(0, 1), cA + hstep, voffA);
        if (wr == 1) PG8_BAR;
        PG8_WAIT_V(2); PG8_BAR;
        PG8_STAGE(PG8_SB(1, 0), cB + kstep, voffB); PG8_STAGE(PG8_SA(1, 0), cA + kstep, voffA); PG8_STAGE(PG8_SB(1, 1), cB + hstep + kstep, voffB);
        PG8_WAIT_V(6); PG8_BAR;
    } else {
        PG8_STAGE(PG8_SB(0, 0), cB, voffB); PG8_STAGE(PG8_SA(0, 0), cA, voffA); PG8_STAGE(PG8_SB(0, 1), cB + hstep, voffB); PG8_STAGE(PG8_SA(0, 1), cA + hstep, voffA);
        if (wr == 1) PG8_BAR;
        PG8_WAIT_V(4); PG8_BAR;
        PG8_STAGE(PG8_SB(1, 0), cB + kstep, voffB); PG8_STAGE(PG8_SA(1, 0), cA + kstep, voffA); PG8_STAGE(PG8_SB(1, 1), cB + hstep + kstep, voffB);
        PG8_WAIT_V(6); PG8_BAR;
    }
    for (;;) {
        const bool has_next = S.next(ui + 1, nxt);
        const char* nA = has_next ? (const char*)g.A + (size_t)nxt.pm * tstep + (size_t)nxt.kofs * 2 : cA; const char* nB = has_next ? (const char*)g.Bt + (size_t)nxt.pn * tstep + (size_t)nxt.kofs * 2 : cB;
        const int unt = cur.nt ? cur.nt : nt;
        for (int t = 0; t < unt; t += 2) {
            const bool last = (t == unt - 2);
            const char* a1 = cA + (size_t)(t + 1) * kstep;
            const char* a2 = last ? nA : cA + (size_t)(t + 2) * kstep; const char* b2 = last ? nB : cB + (size_t)(t + 2) * kstep;
            const char* a3 = a2 + kstep; const char* b3 = b2 + kstep;
            if (last && has_next) S.a_ready(nxt);
            if constexpr (SP2) {
            PG8_LDB(B0, 0, 0); PG8_LDB(B1, 0, 1); PG8_SCHED; PG8_LDA(At, 0, 0); PG8_STAGE(PG8_SA(1, 1), a1 + hstep, voffA);
            PG8_WAIT_V(8); PG8_WAIT_L(0); PG8_BAR; PG8_MMA(0, 0, At, B0); PG8_MMA(0, 1, At, B1); PG8_BAR; PG8_SCHED;
            PG8_LDA(At, 0, 1); PG8_STAGE(PG8_SB(0, 0), b2, voffB); PG8_STAGE(PG8_SB(0, 1), b2 + hstep, voffB); PG8_STAGE(PG8_SA(0, 0), a2, voffA);
            PG8_WAIT_V(8); PG8_WAIT_L(0); PG8_BAR; PG8_MMA(1, 0, At, B0); PG8_MMA(1, 1, At, B1); PG8_BAR; PG8_SCHED;
            PG8_LDB(B0, 1, 0); PG8_LDB(B1, 1, 1); PG8_SCHED; PG8_LDA(At, 1, 0); PG8_STAGE(PG8_SA(0, 1), a2 + hstep, voffA);
            PG8_WAIT_V(8); PG8_WAIT_L(0); PG8_BAR; PG8_MMA(0, 0, At, B0); PG8_MMA(0, 1, At, B1); PG8_BAR; PG8_SCHED;
            PG8_LDA(At, 1, 1); PG8_STAGE(PG8_SB(1, 0), b3, voffB); PG8_STAGE(PG8_SB(1, 1), b3 + hstep, voffB); PG8_STAGE(PG8_SA(1, 0), a3, voffA);
            PG8_WAIT_V(8); PG8_WAIT_L(0); PG8_BAR; PG8_MMA(1, 0, At, B0); PG8_MMA(1, 1, At, B1); PG8_BAR; PG8_SCHED;
            } else {
            PG8_LDB(B0, 0, 0); PG8_SCHED; PG8_LDA(At, 0, 0); PG8_STAGE(PG8_SA(1, 1), a1 + hstep, voffA);
            PG8_WAIT_L(8); PG8_BAR; PG8_WAIT_L(0); PG8_MMA(0, 0, At, B0); PG8_BAR; PG8_SCHED;
            PG8_LDB(B1, 0, 1); PG8_STAGE(PG8_SB(0, 0), b2, voffB);
            PG8_BAR; PG8_WAIT_L(0); PG8_MMA(0, 1, At, B1); PG8_BAR;
            PG8_LDA(At, 0, 1); PG8_STAGE(PG8_SA(0, 0), a2, voffA);
            PG8_BAR; PG8_WAIT_L(0); PG8_MMA(1, 0, At, B0); PG8_BAR; PG8_SCHED;
            PG8_STAGE(PG8_SB(0, 1), b2 + hstep, voffB);
            PG8_WAIT_V(6); PG8_BAR; PG8_MMA(1, 1, At, B1); PG8_BAR;
            PG8_LDB(B0, 1, 0); PG8_SCHED; PG8_LDA(At, 1, 0); PG8_STAGE(PG8_SA(0, 1), a2 + hstep, voffA);
            PG8_WAIT_L(8); PG8_BAR; PG8_WAIT_L(0); PG8_MMA(0, 0, At, B0); PG8_BAR; PG8_SCHED;
            PG8_LDB(B1, 1, 1); PG8_STAGE(PG8_SB(1, 0), b3, voffB);
            PG8_BAR; PG8_WAIT_L(0); PG8_MMA(0, 1, At, B1); PG8_BAR;
            PG8_LDA(At, 1, 1); PG8_STAGE(PG8_SA(1, 0), a3, voffA);
            PG8_BAR; PG8_WAIT_L(0); PG8_MMA(1, 0, At, B0); PG8_BAR; PG8_SCHED;
            PG8_STAGE(PG8_SB(1, 1), b3 + hstep, voffB);
            PG8_WAIT_V(6); PG8_BAR; PG8_MMA(1, 1, At, B1); PG8_BAR;
            }
        }
        if constexpr (ALIGN_EPI) { if (wr == 0) PG8_BAR; }
        if constexpr (!Epi::AFTER_DRAIN) { E(acc, cur, wr, wc, fr, fq); S.done(cur); }
        if (!has_next) break;
#pragma unroll
        for (int a = 0; a < 2; ++a)
#pragma unroll
            for (int b = 0; b < 2; ++b)
#pragma unroll
                for (int m = 0; m < 4; ++m)
#pragma unroll
                    for (int n = 0; n < 2; ++n) acc[a][b][m][n] = (f32x4){0.f, 0.f, 0.f, 0.f};
        cur = nxt; cA = nA; cB = nB; ++ui;
        if constexpr (ALIGN_EPI) { if (wr == 1) PG8_BAR; }
    }
    PG8_WAIT_V(0);
    if constexpr (!ALIGN_EPI) { if (wr == 0) PG8_BAR; }
    PG8_BAR;
    if constexpr (Epi::AFTER_DRAIN) { E.fused(acc, cur, wr, wc, fr, fq, lds, wid, lane); S.done(cur); }
#undef PG8_SA
#undef PG8_SB
#undef PG8_STAGE
#undef PG8_LDA
#undef PG8_LDB
#undef PG8_MMA
#undef PG8_WAIT_V
#undef PG8_WAIT_L
#undef PG8_BAR
#undef PG8_SCHED
}
}

#include <hip/hip_bf16.h>
namespace attn_body {
using bf16=__hip_bfloat16;
using bf16x8=__attribute__((ext_vector_type(8)))short;
using s16x4=__attribute__((ext_vector_type(4)))short;
using f32x16=__attribute__((ext_vector_type(16)))float;
using u32x4=__attribute__((ext_vector_type(4)))unsigned;
constexpr int D=64,PY=3072,PO=1024;
constexpr int NW=8,QBLK=32,QB=QBLK*NW,KVBLK=64;
__device__ __forceinline__ int crow(int r,int hi){return (r&3)+8*(r>>2)+4*hi;}
#define SBAR() __builtin_amdgcn_sched_barrier(0)
typedef __attribute__((address_space(3))) const float* lds_cfptr;
__device__ __forceinline__ void namask(f32x16&p0,f32x16&p1,bool rowok,int u0,lds_cfptr bl){
  const float NEG=-INFINITY;
  asm volatile("":"+v"(u0));
  if(!rowok){
    #pragma unroll
    for(int r=0;r<16;++r){p0[r]=NEG;p1[r]=NEG;}
  } else {
    #pragma unroll
    for(int g=0;g<4;++g){
      #pragma unroll
      for(int k=0;k<4;++k){const int r=4*g+k, cr=8*g+k;
        float b0=bl[cr], b1=bl[cr+32]; asm volatile("":"+v"(b0),"+v"(b1));
        p0[r]=((unsigned)(u0+cr)<16u)?p0[r]+b0:NEG; p1[r]=((unsigned)(u0+cr+32)<16u)?p1[r]+b1:NEG;}
      SBAR();
    }
  }
}


constexpr int NSLOT=3, SLOTB=8192, SLOTV=16384;
constexpr int LDS_K=0, LDS_V=NSLOT*SLOTB, LDS_WS=LDS_V+NSLOT*SLOTV, LDS_OST=LDS_WS+NW*64*4, LDS_RPB=LDS_OST+NW*4096, RPB_PAD=64, LDS_BYTES=LDS_RPB+640*4;
constexpr float C2=0.125f*1.4426950408889634f;
__device__ __forceinline__ void glds16(const void*gsrc,unsigned lds_dst){unsigned keep;
  asm volatile("s_mov_b32 %0, m0\n\ts_mov_b32 m0, %2\n\ts_nop 0\n\tglobal_load_lds_dwordx4 %1, off\n\ts_mov_b32 m0, %0":"=&s"(keep):"v"(gsrc),"s"(lds_dst):"memory");}
__device__ __forceinline__ float max3f(float a,float b,float c){float r;asm("v_max3_f32 %0, %1, %2, %3":"=v"(r):"v"(a),"v"(b),"v"(c));return r;}
__device__ __forceinline__ float max2f(float a,float b){float r;asm("v_max_f32_e32 %0, %1, %2":"=v"(r):"v"(a),"v"(b));return r;}
__device__ __forceinline__ float fadd_s(float a,float b){float r;asm("v_add_f32_e32 %0, %1, %2":"=v"(r):"v"(a),"v"(b));return r;}
__device__ __forceinline__ float fsub_s(float a,float b){float r;asm("v_sub_f32_e32 %0, %1, %2":"=v"(r):"v"(a),"v"(b));return r;}
typedef float f32x2_t __attribute__((ext_vector_type(2))); typedef __bf16 bf16x2_t __attribute__((ext_vector_type(2)));
__device__ __forceinline__ unsigned cvtpk_s(float lo,float hi){f32x2_t v={lo,hi};bf16x2_t b=__builtin_convertvector(v,bf16x2_t);return __builtin_bit_cast(unsigned,b);}
#define WAIT_BAR(N) asm volatile("s_waitcnt vmcnt(" #N ") lgkmcnt(0)\n\ts_barrier":::"memory")

__device__ __forceinline__ void qkt(f32x16&p0,f32x16&p1,const char*Kslot,const bf16x8*qr,const f32x16&negm,int r32,int hi){
  const char*kb=Kslot+hi*1024+r32*16;
  #pragma unroll
  for(int d0=0;d0<4;++d0){
    const bf16x8 b0=*reinterpret_cast<const bf16x8*>(kb+d0*2048);
    const bf16x8 b1=*reinterpret_cast<const bf16x8*>(kb+d0*2048+512);
    if(d0==0){p0=__builtin_amdgcn_mfma_f32_32x32x16_bf16(b0,qr[0],negm,0,0,0);p1=__builtin_amdgcn_mfma_f32_32x32x16_bf16(b1,qr[0],negm,0,0,0);}
    else{p0=__builtin_amdgcn_mfma_f32_32x32x16_bf16(b0,qr[d0],p0,0,0,0);p1=__builtin_amdgcn_mfma_f32_32x32x16_bf16(b1,qr[d0],p1,0,0,0);}}
}
typedef __attribute__((address_space(3))) const char* lds_cptr;
typedef short v4i16_t __attribute__((ext_vector_type(4)));
__device__ __forceinline__ void kload8(bf16x8*kf,lds_cptr kp){
  kf[0]=*(const __attribute__((address_space(3))) bf16x8*)(kp);      kf[1]=*(const __attribute__((address_space(3))) bf16x8*)(kp+512);
  kf[2]=*(const __attribute__((address_space(3))) bf16x8*)(kp+2048); kf[3]=*(const __attribute__((address_space(3))) bf16x8*)(kp+2560);
  kf[4]=*(const __attribute__((address_space(3))) bf16x8*)(kp+4096); kf[5]=*(const __attribute__((address_space(3))) bf16x8*)(kp+4608);
  kf[6]=*(const __attribute__((address_space(3))) bf16x8*)(kp+6144); kf[7]=*(const __attribute__((address_space(3))) bf16x8*)(kp+6656);
}
__device__ __forceinline__ void kload2(bf16x8*kf,lds_cptr kp,int j){ kf[2*j]=*(const __attribute__((address_space(3))) bf16x8*)(kp+j*2048); kf[2*j+1]=*(const __attribute__((address_space(3))) bf16x8*)(kp+j*2048+512); }
__device__ __forceinline__ s16x4 vtr(lds_cptr p){ return __builtin_bit_cast(s16x4,__builtin_amdgcn_ds_read_tr16_b64_v4i16((__attribute__((address_space(3))) v4i16_t*)p)); }
__device__ __forceinline__ float rowmax(const f32x16&p0,const f32x16&p1){
  float a=max3f(p0[0],p0[1],p1[0]),b=max3f(p0[2],p0[3],p1[1]);a=max3f(a,p1[2],p1[3]);
  #pragma unroll
  for(int r=4;r<16;r+=4){a=max3f(a,p0[r],p0[r+1]);b=max3f(b,p0[r+2],p0[r+3]);a=max3f(a,p1[r],p1[r+1]);b=max3f(b,p1[r+2],p1[r+3]);}
  const float m=max2f(a,b);
  auto rr=__builtin_amdgcn_permlane32_swap(__float_as_uint(m),__float_as_uint(m),false,false);
  return max2f(__uint_as_float(rr[0]),__uint_as_float(rr[1]));
}
template<int ND> __device__ __forceinline__ void pv(f32x16*o,int vb,bf16x8 pa0,bf16x8 pa1,bf16x8 pa2,bf16x8 pa3){
  #pragma unroll
  for(int d0=0;d0<ND;++d0){s16x4 lo[4],hi[4];
    #pragma unroll
    for(int ks=0;ks<4;++ks){
      asm volatile("ds_read_b64_tr_b16 %0,%1 offset:%c2":"=&v"(lo[ks]):"v"(vb),"i"(d0*4096+ks*1024):"memory");
      asm volatile("ds_read_b64_tr_b16 %0,%1 offset:%c2":"=&v"(hi[ks]):"v"(vb),"i"(d0*4096+ks*1024+512):"memory");}
    asm volatile("s_waitcnt lgkmcnt(0)":::"memory");SBAR();
    #define PK(k) (bf16x8){lo[k][0],lo[k][1],lo[k][2],lo[k][3],hi[k][0],hi[k][1],hi[k][2],hi[k][3]}
    o[d0]=__builtin_amdgcn_mfma_f32_32x32x16_bf16(pa0,PK(0),o[d0],0,0,0);
    o[d0]=__builtin_amdgcn_mfma_f32_32x32x16_bf16(pa1,PK(1),o[d0],0,0,0);
    o[d0]=__builtin_amdgcn_mfma_f32_32x32x16_bf16(pa2,PK(2),o[d0],0,0,0);
    o[d0]=__builtin_amdgcn_mfma_f32_32x32x16_bf16(pa3,PK(3),o[d0],0,0,0);
    #undef PK
  }
}

#ifndef ATTN_STORE16
#define ATTN_STORE16(p,v) (*(u32x4*)(p)=(v))
#endif
template<int MODE,int THRL,int DV> __device__ __forceinline__ void attn_unit(const bf16*Qp,const bf16*__restrict__ Kc,const bf16*__restrict__ Vc,int ctx_row0,int lat_row0,int NT,bf16*Op,int qrow0,int kr0,const float*rpbh,char*shm){
  int tid_=threadIdx.x; asm volatile("":"+v"(tid_));
  const int tid=tid_,lane=tid&63,r32=lane&31,hi=lane>>5; const int wid=__builtin_amdgcn_readfirstlane(tid>>6);
  const bf16*Qw=Qp+(long)(wid*QBLK)*PY;
  const lds_cptr shm3=(lds_cptr)shm;
  const unsigned lds0=(unsigned)(uintptr_t)shm;
  float*wsf=(float*)(shm+LDS_WS)+wid*64;
  const bf16*ksrc=Kc+(long)lane*PY+wid*8;
  const bf16*vsrc=Vc+(long)(16*(wid&3)+(lane>>2))*PY+(wid>>2)*32+(lane&3)*8;
  const unsigned kdst=lds0+LDS_K+wid*1024, vdst=lds0+LDS_V+wid*1024;
  #define TROW(t) ((t)<4?ctx_row0+64*(t):lat_row0+64*((t)-4))
  #define DMA_K(t,slot) glds16(ksrc+(long)TROW(t)*PY,(unsigned)__builtin_amdgcn_readfirstlane(kdst+(slot)))
  #define DMA_V(t,slot) do{ glds16(vsrc+(long)TROW(t)*PY,(unsigned)__builtin_amdgcn_readfirstlane(vdst+2*(slot))); \
      if(DV==128) glds16(vsrc+64+(long)TROW(t)*PY,(unsigned)__builtin_amdgcn_readfirstlane(vdst+2*(slot)+8192)); }while(0)
  const int vb0=(int)(lds0+LDS_V)+((lane>>4)&1)*32+(lane&3)*8+(4*hi+((lane&15)>>2))*64;
  const char*Kbase=shm+LDS_K; bf16x8 kf[8];
  const lds_cptr kp0=shm3+LDS_K+hi*1024+r32*16; const lds_cptr vp0=shm3+LDS_V+((lane>>4)&1)*32+(lane&3)*8+(4*hi+((lane&15)>>2))*64;
  DMA_K(0,0);DMA_V(0,0);DMA_K(1,SLOTB);
  bf16x8 qr[4];
  #pragma unroll
  for(int d0=0;d0<4;++d0)qr[d0]=*reinterpret_cast<const bf16x8*>(&Qw[(long)r32*PY+d0*16+hi*8]);
  float z0_=0.f; asm volatile("":"+v"(z0_)); f32x16 zv_;
  #pragma unroll
  for(int r=0;r<16;++r)zv_[r]=z0_;
  float mhat=0.f,l_reg=0.f;constexpr int ND=DV/32; f32x16 o[ND];
  #pragma unroll
  for(int d_=0;d_<ND;++d_)o[d_]=zv_;
  f32x16 negm=zv_;asm volatile("":"+v"(negm));
  if(MODE==1){ __attribute__((address_space(3))) float*tabw=(__attribute__((address_space(3))) float*)(shm3+LDS_RPB)+RPB_PAD; for(int i_=tid;i_<465;i_+=NW*64)tabw[i_]=rpbh[i_]*1.4426950408889634f; }
  #define CMASK(P0,P1,t) do{ if(MODE==1){ if((t)>=4){ int t2_=threadIdx.x; asm volatile("":"+v"(t2_)); const int w2_=__builtin_amdgcn_readfirstlane(t2_>>6), r2_=t2_&31, h2_=(t2_>>5)&1; \
      const int na_qr=qrow0+(w2_>>1), na_qc=32*(w2_&1)+r2_, na_rs=min(max(na_qr-4,0),24), na_cs=min(max(na_qc-8,0),48); const int kr_=kr0+(t)-4; \
      namask(P0,P1,(unsigned)(kr_-na_rs)<8u,4*h2_-na_cs,(lds_cfptr)(shm3+LDS_RPB)+RPB_PAD+15-na_qc+4*h2_+(kr_-na_qr+7)*31); } } }while(0)
  bool resc=false;
  #define START(P0,P1) do{ const float rm=rowmax(P0,P1); resc=false; \
    { const float dl=rm; mhat=fadd_s(mhat,dl); \
      _Pragma("unroll") for(int r=0;r<16;++r){P0[r]=fsub_s(P0[r],dl);P1[r]=fsub_s(P1[r],dl);} \
      _Pragma("unroll") for(int r=0;r<16;++r)negm[r]=-mhat; asm volatile("":"+v"(negm)); } \
    _Pragma("unroll") for(int r=0;r<16;++r)P0[r]=__builtin_amdgcn_exp2f(P0[r]); }while(0)
  #define RESC() do{ if(resc){ asm volatile("s_waitcnt lgkmcnt(0)":::"memory"); \
      _Pragma("unroll") for(int d_=0;d_<ND;++d_) _Pragma("unroll") for(int r=0;r<16;++r)o[d_][r]*=wsf[crow(r,hi)]; } }while(0)
  f32x16 pA0,pA1,pB0,pB1;
  int sl_prev=0,sl_cur=0,sl_next=SLOTB;
  #define ROT() do{sl_prev=sl_cur;sl_cur=sl_next;sl_next=(sl_next==(NSLOT-1)*SLOTB)?0:sl_next+SLOTB;}while(0)
  DMA_K(2,2*SLOTB);
  WAIT_BAR(3);
  qkt(pA0,pA1,Kbase,qr,negm,r32,hi);asm volatile("s_nop 15\n\ts_nop 7":"+v"(pA0),"+v"(pA1));CMASK(pA0,pA1,0);
  START(pA0,pA1);
  _Pragma("unroll") for(int r=0;r<16;++r)pA1[r]=__builtin_amdgcn_exp2f(pA1[r]);
  WAIT_BAR(0);
  DMA_K(3,0);DMA_V(1,SLOTB);
  ROT();
  kload8(kf,kp0+sl_cur);
  #define WAIT_KV() do{ if(DV==128){WAIT_BAR(3);}else{WAIT_BAR(2);} }while(0)
  #define WAIT_V() do{ if(DV==128){WAIT_BAR(2);}else{WAIT_BAR(1);} }while(0)
  WAIT_KV();
  s16x4 vlo[8],vhi[8]; u32x4 pw0,pw1,pw2,pw3;
  #define PKW(P,B) cvtpk_s(P[B],P[B+1])
  #define PAF(k) __builtin_bit_cast(bf16x8,pw##k)
  #define VFR(i) (bf16x8){vlo[i][0],vlo[i][1],vlo[i][2],vlo[i][3],vhi[i][0],vhi[i][1],vhi[i][2],vhi[i][3]}
  #define PIN(x) asm volatile("":"+v"(x))
  #define MX3(a,b,c) __builtin_fmaxf(__builtin_fmaxf((a),(b)),(c))
  #define GAPA(MF,A0,A1,A2,A3,W0,W1,PW) do{ MF; sacc+=A0; sacc+=A1; sacc+=A2; sacc+=A3; PIN(sacc); W0; W1; PIN(PW); SBAR(); }while(0)
  #define EX(v) __builtin_amdgcn_exp2f(v)
  #define GAPB(MF,X,B) do{ MF; X[B]=EX(X[B]); X[B+1]=EX(X[B+1]); X[B+2]=EX(X[B+2]); X[B+3]=EX(X[B+3]); PIN(X); SBAR(); }while(0)
  #define VRD(i) do{ vlo[i]=vtr(vp_+(((i)>>2)*4096+((i)&3)*1024)); vhi[i]=vtr(vp_+(((i)>>2)*4096+((i)&3)*1024+512)); }while(0)
  #define VRD2(i) do{ vlo[i]=vtr(vp_+(8192+((i)>>2)*4096+((i)&3)*1024)); vhi[i]=vtr(vp_+(8192+((i)>>2)*4096+((i)&3)*1024+512)); }while(0)
  #define GAPC(MF) do{ MF; SBAR(); }while(0)
  #define KRD(G,j) do{ if(G){ kload2(kf,kp0+sl_next,j); SBAR(); } }while(0)
  #define STEP(C0,C1,P0,P1,t,GK,GV,GL) do{ SBAR(); \
    const lds_cptr vp_=vp0+2*sl_prev; \
    VRD(0); SBAR(); float sacc=(P0[0]+P0[1]); \
    GAPA(C0=__builtin_amdgcn_mfma_f32_32x32x16_bf16(kf[0],qr[0],negm,0,0,0), P0[2],P0[3],P0[4],P0[5],     pw0[0]=PKW(P0,0), pw0[1]=PKW(P0,2), pw0); \
    VRD(4); SBAR(); GAPA(C1=__builtin_amdgcn_mfma_f32_32x32x16_bf16(kf[1],qr[0],negm,0,0,0), P0[6],P0[7],P0[8],P0[9],     pw0[2]=PKW(P0,4), pw0[3]=PKW(P0,6), pw0); \
    VRD(1); SBAR(); GAPA(C0=__builtin_amdgcn_mfma_f32_32x32x16_bf16(kf[2],qr[1],C0,0,0,0),   P0[10],P0[11],P0[12],P0[13], pw1[0]=PKW(P0,8), pw1[1]=PKW(P0,10), pw1); \
    VRD(5); SBAR(); GAPA(C1=__builtin_amdgcn_mfma_f32_32x32x16_bf16(kf[3],qr[1],C1,0,0,0),   P0[14],P0[15],P1[0],P1[1],   pw1[2]=PKW(P0,12),pw1[3]=PKW(P0,14), pw1); \
    VRD(2); SBAR(); GAPA(C0=__builtin_amdgcn_mfma_f32_32x32x16_bf16(kf[4],qr[2],C0,0,0,0),   P1[2],P1[3],P1[4],P1[5],     pw2[0]=PKW(P1,0), pw2[1]=PKW(P1,2), pw2); \
    VRD(6); SBAR(); GAPA(C1=__builtin_amdgcn_mfma_f32_32x32x16_bf16(kf[5],qr[2],C1,0,0,0),   P1[6],P1[7],P1[8],P1[9],     pw2[2]=PKW(P1,4), pw2[3]=PKW(P1,6), pw2); \
    VRD(3); SBAR(); GAPA(C0=__builtin_amdgcn_mfma_f32_32x32x16_bf16(kf[6],qr[3],C0,0,0,0),   P1[10],P1[11],P1[12],P1[13], pw3[0]=PKW(P1,8), pw3[1]=PKW(P1,10), pw3); \
    VRD(7); SBAR(); GAPA(C1=__builtin_amdgcn_mfma_f32_32x32x16_bf16(kf[7],qr[3],C1,0,0,0),   P1[14],P1[15],0.f,0.f,       pw3[2]=PKW(P1,12),pw3[3]=PKW(P1,14), pw3); \
    l_reg+=sacc; \
    if(GK){DMA_K((t)+3,sl_cur);} if(GV){DMA_V((t)+1,sl_next);} \
    CMASK(C0,C1,t); \
    { float a=MX3(C0[0],C0[1],C1[0]),b=MX3(C0[2],C0[3],C1[1]); a=MX3(a,C1[2],C1[3]); \
      _Pragma("unroll") for(int r=4;r<16;r+=4){a=MX3(a,C0[r],C0[r+1]);b=MX3(b,C0[r+2],C0[r+3]);a=MX3(a,C1[r],C1[r+1]);b=MX3(b,C1[r+2],C1[r+3]);} \
      float rm=__builtin_fmaxf(a,b); { auto rr=__builtin_amdgcn_permlane32_swap(__float_as_uint(rm),__float_as_uint(rm),false,false); rm=__builtin_fmaxf(__uint_as_float(rr[0]),__uint_as_float(rr[1])); } \
      resc=false; \
      if(__builtin_expect(__any(rm>(float)THRL),0)){ const float dl=__builtin_fmaxf(rm,0.f); mhat+=dl; \
        _Pragma("unroll") for(int r=0;r<16;++r){C0[r]-=dl;C1[r]-=dl;} \
        _Pragma("unroll") for(int r=0;r<16;++r)negm[r]=-mhat; asm volatile("":"+v"(negm)); \
        const float f=__builtin_amdgcn_exp2f(-dl); l_reg*=f; if(hi==0)wsf[r32]=f; resc=true; } } \
    SBAR(); \
    if constexpr(DV==64){ \
    GAPB(o[0]=__builtin_amdgcn_mfma_f32_32x32x16_bf16(PAF(0),VFR(0),o[0],0,0,0), C0,0); \
    GAPB(o[1]=__builtin_amdgcn_mfma_f32_32x32x16_bf16(PAF(0),VFR(4),o[1],0,0,0), C0,4); \
    KRD(GL,0); GAPB(o[0]=__builtin_amdgcn_mfma_f32_32x32x16_bf16(PAF(1),VFR(1),o[0],0,0,0), C0,8); \
    KRD(GL,1); GAPB(o[1]=__builtin_amdgcn_mfma_f32_32x32x16_bf16(PAF(1),VFR(5),o[1],0,0,0), C0,12); \
    KRD(GL,2); GAPB(o[0]=__builtin_amdgcn_mfma_f32_32x32x16_bf16(PAF(2),VFR(2),o[0],0,0,0), C1,0); \
    KRD(GL,3); GAPB(o[1]=__builtin_amdgcn_mfma_f32_32x32x16_bf16(PAF(2),VFR(6),o[1],0,0,0), C1,4); \
    GAPB(o[0]=__builtin_amdgcn_mfma_f32_32x32x16_bf16(PAF(3),VFR(3),o[0],0,0,0), C1,8); \
    GAPB(o[1]=__builtin_amdgcn_mfma_f32_32x32x16_bf16(PAF(3),VFR(7),o[1],0,0,0), C1,12); \
    } else {   \
    GAPB(o[0]=__builtin_amdgcn_mfma_f32_32x32x16_bf16(PAF(0),VFR(0),o[0],0,0,0), C0,0);  VRD2(0); SBAR(); \
    GAPB(o[1]=__builtin_amdgcn_mfma_f32_32x32x16_bf16(PAF(0),VFR(4),o[1],0,0,0), C0,4);  VRD2(4); SBAR(); \
    GAPB(o[0]=__builtin_amdgcn_mfma_f32_32x32x16_bf16(PAF(1),VFR(1),o[0],0,0,0), C0,8);  VRD2(1); SBAR(); \
    GAPB(o[1]=__builtin_amdgcn_mfma_f32_32x32x16_bf16(PAF(1),VFR(5),o[1],0,0,0), C0,12); VRD2(5); SBAR(); \
    GAPB(o[0]=__builtin_amdgcn_mfma_f32_32x32x16_bf16(PAF(2),VFR(2),o[0],0,0,0), C1,0);  VRD2(2); SBAR(); \
    GAPB(o[1]=__builtin_amdgcn_mfma_f32_32x32x16_bf16(PAF(2),VFR(6),o[1],0,0,0), C1,4);  VRD2(6); SBAR(); \
    GAPB(o[0]=__builtin_amdgcn_mfma_f32_32x32x16_bf16(PAF(3),VFR(3),o[0],0,0,0), C1,8);  VRD2(3); SBAR(); \
    GAPB(o[1]=__builtin_amdgcn_mfma_f32_32x32x16_bf16(PAF(3),VFR(7),o[1],0,0,0), C1,12); VRD2(7); SBAR(); \
    KRD(GL,0); GAPC(o[ND-2]=__builtin_amdgcn_mfma_f32_32x32x16_bf16(PAF(0),VFR(0),o[ND-2],0,0,0)); \
    KRD(GL,1); GAPC(o[ND-1]=__builtin_amdgcn_mfma_f32_32x32x16_bf16(PAF(0),VFR(4),o[ND-1],0,0,0)); \
    KRD(GL,2); GAPC(o[ND-2]=__builtin_amdgcn_mfma_f32_32x32x16_bf16(PAF(1),VFR(1),o[ND-2],0,0,0)); \
    KRD(GL,3); GAPC(o[ND-1]=__builtin_amdgcn_mfma_f32_32x32x16_bf16(PAF(1),VFR(5),o[ND-1],0,0,0)); \
    GAPC(o[ND-2]=__builtin_amdgcn_mfma_f32_32x32x16_bf16(PAF(2),VFR(2),o[ND-2],0,0,0)); \
    GAPC(o[ND-1]=__builtin_amdgcn_mfma_f32_32x32x16_bf16(PAF(2),VFR(6),o[ND-1],0,0,0)); \
    GAPC(o[ND-2]=__builtin_amdgcn_mfma_f32_32x32x16_bf16(PAF(3),VFR(3),o[ND-2],0,0,0)); \
    GAPC(o[ND-1]=__builtin_amdgcn_mfma_f32_32x32x16_bf16(PAF(3),VFR(7),o[ND-1],0,0,0)); \
    } \
    }while(0)
  int t=1;
  for(;t+5<NT;t+=2){
    STEP(pB0,pB1,pA0,pA1,t,true,true,true);     WAIT_KV(); RESC(); ROT();
    STEP(pA0,pA1,pB0,pB1,t+1,true,true,true);   WAIT_KV(); RESC(); ROT();
  }
  #define ENDW(tt) do{ if((tt)+3<NT){WAIT_KV();} else if((tt)+2<NT){WAIT_V();} else {WAIT_BAR(0);} }while(0)
  for(;t+1<NT;t+=2){
    STEP(pB0,pB1,pA0,pA1,t,(t+3<NT),(t+1<NT),(t+1<NT));       ENDW(t);   RESC(); ROT();
    STEP(pA0,pA1,pB0,pB1,t+1,(t+4<NT),(t+2<NT),(t+2<NT));     ENDW(t+1); RESC(); ROT();
  }
  STEP(pB0,pB1,pA0,pA1,NT-1,false,false,false); RESC();
  { float sacc=pB0[0]+pB0[1]; _Pragma("unroll") for(int r=2;r<16;++r)sacc+=pB0[r]; _Pragma("unroll") for(int r=0;r<16;++r)sacc+=pB1[r]; l_reg+=sacc;
    pw0=(u32x4){PKW(pB0,0),PKW(pB0,2),PKW(pB0,4),PKW(pB0,6)};pw1=(u32x4){PKW(pB0,8),PKW(pB0,10),PKW(pB0,12),PKW(pB0,14)};pw2=(u32x4){PKW(pB1,0),PKW(pB1,2),PKW(pB1,4),PKW(pB1,6)};pw3=(u32x4){PKW(pB1,8),PKW(pB1,10),PKW(pB1,12),PKW(pB1,14)};
    SBAR(); pv<ND>(o,vb0+2*sl_cur,PAF(0),PAF(1),PAF(2),PAF(3)); }
  #undef PKW
  #undef PAF
  #undef VFR
  #undef PIN
  #undef MX3
  #undef GAPA
  #undef GAPB
  #undef EX
  #undef VRD
  #undef KRD
  #undef VRD2
  #undef GAPC
  #undef WAIT_KV
  #undef WAIT_V
  #undef STEP
  #undef ENDW
  {auto rr=__builtin_amdgcn_permlane32_swap(__float_as_uint(l_reg),__float_as_uint(l_reg),false,false);l_reg=__uint_as_float(rr[0])+__uint_as_float(rr[1]);}
  if(hi==0)wsf[32+r32]=l_reg;asm volatile("s_waitcnt lgkmcnt(0)":::"memory");
  float rli[16];
  #pragma unroll
  for(int r=0;r<16;++r)rli[r]=__builtin_amdgcn_rcpf(wsf[32+crow(r,hi)]);
  bf16*Ow=Op+(long)(wid*QBLK)*PO;
  { bf16*stg=(bf16*)(shm+LDS_OST)+wid*2048;
    #pragma unroll
    for(int hf=0;hf<ND/2;++hf){
      #pragma unroll
      for(int r=0;r<16;++r){const int orow=crow(r,hi);
        #pragma unroll
        for(int d0=0;d0<2;++d0)stg[orow*64+d0*32+r32]=__float2bfloat16(o[2*hf+d0][r]*rli[r]);}
      asm volatile("s_waitcnt lgkmcnt(0)":::"memory");
      #pragma unroll
      for(int i=0;i<4;++i){const int row=i*8+(lane>>3),ch=lane&7; const u32x4 v=*(const u32x4*)(stg+row*64+ch*8); ATTN_STORE16(Ow+(long)row*PO+hf*64+ch*8,v);}
      asm volatile("s_waitcnt lgkmcnt(0)":::"memory");
    } }
  asm volatile("s_waitcnt lgkmcnt(0)\n\ts_barrier":::"memory");
  #undef TROW
  #undef DMA_K
  #undef DMA_V
  #undef CMASK
  #undef START
  #undef RESC
  #undef ROT
}
constexpr int ATTN_LDS_BYTES=LDS_BYTES;
#undef SBAR
#undef WAIT_BAR
}

#define GAS __attribute__((address_space(1)))
#define LAS __attribute__((address_space(3)))
typedef unsigned v4u __attribute__((ext_vector_type(4)));
typedef float f32x4 __attribute__((ext_vector_type(4)));
typedef short bf16x8 __attribute__((ext_vector_type(8)));
typedef GAS unsigned gu32;
typedef GAS unsigned long long gu64;
#define RLX_AGENT __ATOMIC_RELAXED, __HIP_MEMORY_SCOPE_AGENT
#define LDS_WAIT() asm volatile("s_waitcnt lgkmcnt(0)" ::: "memory")
#define VM_WAIT() asm volatile("s_waitcnt vmcnt(0)" ::: "memory")
__device__ __forceinline__ unsigned long long rt() { return __builtin_amdgcn_s_memrealtime(); }
__device__ __forceinline__ unsigned pk2(float lo, float hi) { return (unsigned)f2bf(lo) | ((unsigned)f2bf(hi) << 16); }

#define XB_TMO      128
#define XB_XCNT(j)  (256  + 64 * (j))
#define XB_XSUB(j)  (1280 + 64 * (j))
#define XB_XGEN(j)  (2304 + 64 * (j))
#define XB_TOP      3328
#define XB_TOPGEN   3392
#define XCD_BAR_WORDS 3456
#define XB_SPIN_CAP (1u << 18)

__device__ __forceinline__ unsigned xb_ld(unsigned* p)              { return __hip_atomic_load(p, __ATOMIC_RELAXED, __HIP_MEMORY_SCOPE_AGENT); }
__device__ __forceinline__ unsigned xb_add(unsigned* p, unsigned v) { return __hip_atomic_fetch_add(p, v, __ATOMIC_RELAXED, __HIP_MEMORY_SCOPE_AGENT); }
__device__ __forceinline__ unsigned xb_xcc_id() { return (unsigned)__builtin_amdgcn_s_getreg((3 << 11) | 20) & 0xFu; }
#define XB_SPIN(cond, bar) do { unsigned _sp = 0; while (cond) { __builtin_amdgcn_s_sleep(1); \
    if ((++_sp & 255u) == 0u) { if (xb_ld(&(bar)[XB_TMO])) break; if (_sp > XB_SPIN_CAP) { atomicAdd(&(bar)[XB_TMO], 1u); break; } } } } while (0)

struct XcdBarrier {
    unsigned* bar; unsigned x;
    volatile LAS unsigned* st;
};

__device__ __forceinline__ XcdBarrier xcd_barrier_post(unsigned* bar, volatile LAS unsigned* st) {
    XcdBarrier b; b.bar = bar; b.x = xb_xcc_id(); b.st = st;
    if (threadIdx.x == 0) (void)xb_add(&bar[XB_XCNT(b.x)], 1u);
    return b;
}
__device__ __forceinline__ void xcd_barrier_complete(unsigned* bar, unsigned x, unsigned& nloc, unsigned& nx) {
    const unsigned G = gridDim.x * gridDim.y * gridDim.z;
    unsigned sum, cnt, mine, sp = 0u;
    for (;;) {
        sum = 0u; cnt = 0u; mine = 0u;
#pragma unroll
        for (unsigned j = 0; j < 16; ++j) { const unsigned c = xb_ld(&bar[XB_XCNT(j)]); sum += c; cnt += (c > 0u) ? 1u : 0u; mine = (j == x) ? c : mine; }
        if (sum == G) break;
        __builtin_amdgcn_s_sleep(1);
        if ((++sp & 255u) == 0u) { if (xb_ld(&bar[XB_TMO])) break; if (sp > XB_SPIN_CAP) { atomicAdd(&bar[XB_TMO], 1u); break; } }
    }
    nloc = mine > 0u ? mine : 1u; nx = cnt > 0u ? cnt : 1u;
}

__device__ __forceinline__ void xcd_barrier(const XcdBarrier& b) {
    asm volatile("s_waitcnt vmcnt(0)" ::: "memory");
    __syncthreads();
    if (threadIdx.x == 0) {
        unsigned* bar = b.bar;
        __builtin_amdgcn_s_waitcnt(0);
        unsigned nloc = b.st[0], nx = b.st[1];
        if (nloc == 0u) { xcd_barrier_complete(bar, b.x, nloc, nx); b.st[0] = nloc; b.st[1] = nx; }
        const unsigned old = xb_add(&bar[XB_XSUB(b.x)], 1u);
        const unsigned gen = old / nloc;
        if (old + 1u == (gen + 1u) * nloc) {
            __builtin_amdgcn_fence(__ATOMIC_RELEASE, "agent");
            asm volatile("s_waitcnt vmcnt(0)" ::: "memory");
            const unsigned og = xb_add(&bar[XB_TOP], 1u);
            const unsigned tg = og / nx;
            if (og + 1u == (tg + 1u) * nx) xb_add(&bar[XB_TOPGEN], 1u);
            else XB_SPIN(xb_ld(&bar[XB_TOPGEN]) == tg, bar);
            __builtin_amdgcn_fence(__ATOMIC_ACQUIRE, "agent");
            xb_add(&bar[XB_XGEN(b.x)], 1u);
            asm volatile("s_waitcnt vmcnt(0)" ::: "memory");
        } else {
            XB_SPIN(xb_ld(&bar[XB_XGEN(b.x)]) == gen, bar);
            __builtin_amdgcn_fence(__ATOMIC_ACQUIRE, "agent");
            asm volatile("s_waitcnt vmcnt(0)" ::: "memory");
        }
    }
    __syncthreads();
}

constexpr int NWAVES = 8;
constexpr int N_PHASES = 12;
constexpr int CW_BAR = 4096;
static_assert((CW_BAR + 4 * XCD_BAR_WORDS) * 4 <= (int)CTL_ZERO_BYTES, "CTL words inside the memset region");
constexpr int RING_OFF = 0, RING_BYTES = 131072;
constexpr int LDSCTL_OFF = RING_BYTES, MISC_OFF = LDSCTL_OFF + 320;
constexpr int TAB_OFF = RING_BYTES + 1024, TAB_FLOATS = 2048 + 256;
constexpr int LDS_BYTES = 147456;
static_assert(MISC_OFF + 128 <= TAB_OFF && TAB_OFF + TAB_FLOATS * 4 <= LDS_BYTES, "LDS map");

struct Args { const float* in[25]; float* out; unsigned char* ws; int ph_lo, ph_hi, li, flags; };
struct Frame {
    LAS unsigned char* lds; volatile LAS unsigned* MISC; gu32* ctl;
    int tid, lane, wave, vcu, G;
};

__device__ __forceinline__ float wave_sum(float v) {
#pragma unroll
    for (int o = 1; o < 64; o <<= 1) v += __shfl_xor(v, o);
    return v;
}
__device__ __forceinline__ void wsrc_block(int kind, int nb, int& src0, int& perm, int& gap) {
    gap = 0;
    if (kind == 0) { src0 = 32 * nb; perm = 0; }
    else if (kind == 1) { const int tile = nb >> 3, l = nb & 7, bj = l >> 2, wc = l & 3; src0 = bj * FF + 128 * tile + 32 * wc; perm = 1; }
    else { const int tile = nb >> 3, l = nb & 7, grp = tile >> 1; if (grp == 2 || grp == 5) { src0 = 32 * nb; perm = 1; }
           else { const int bj = l >> 2, wc = l & 3; src0 = 256 * tile + 64 * wc + 16 * bj; perm = 2; gap = 16; } }
}
__device__ __forceinline__ void p0_transpose_item(const float* W, int K, int N, bf16_t* WT, int kind, LAS float* scr, int item, int lane) {
    const int nblk = N / 32, kb = item / nblk, nb = item % nblk, k0 = 64 * kb; int src0, perm, gap; wsrc_block(kind, nb, src0, perm, gap);
    const int scol = src0 + (lane & 31) + ((lane & 16) ? gap : 0);
#pragma unroll 8
    for (int i = 0; i < 32; ++i) { const int kk = 2 * i + (lane >> 5); scr[kk * 33 + (lane & 31)] = W[(size_t)(k0 + kk) * N + scol]; }
    LDS_WAIT(); asm volatile("" ::: "memory");
    const int c = lane & 7;
#pragma unroll
    for (int j = 0; j < 4; ++j) { const int n = (lane >> 3) + 8 * j;
        const int sn = perm == 1 ? pg8::perm32(n) : perm == 2 ? (16 * ((n >> 3) & 1) + 8 * ((n >> 2) & 1) + 4 * (n >> 4) + (n & 3)) : n; const LAS float* s = scr + (8 * c) * 33 + sn;
        v4u o; o.x = pk2(s[0 * 33], s[1 * 33]); o.y = pk2(s[2 * 33], s[3 * 33]); o.z = pk2(s[4 * 33], s[5 * 33]); o.w = pk2(s[6 * 33], s[7 * 33]);
        *(GAS v4u*)(WT + (size_t)(32 * nb + n) * K + k0 + 8 * c) = o; }
    LDS_WAIT(); asm volatile("" ::: "memory");
}
__device__ __forceinline__ void weight_copies(Frame& F, const Args& a, int part, int gw, int NGW) {
    unsigned char* ws = a.ws;
    LAS float* scr = (LAS float*)(F.lds + RING_OFF + F.wave * 16384);
    constexpr int I_GU = (D / 64) * (2 * FF / 32), I_D = (FF / 64) * (D / 32), I_IN = (D / 64) * (NIN / 32), I_OUT = (D / 64) * (D / 32);
    if (part == 0) {
        for (int it = gw; it < I_GU; it += NGW) p0_transpose_item(a.in[9], D, 2 * FF, (bf16_t*)(ws + WS_WGU1), 1, scr, it, F.lane);
    } else if (part == 2) {
        for (int it = gw; it < I_D; it += NGW) p0_transpose_item(a.in[10], FF, D, (bf16_t*)(ws + WS_WD1), 0, scr, it, F.lane);
    } else {
        for (int it = gw; it < I_GU + I_D + I_IN + I_OUT; it += NGW) {
            int r = it;
            if (r < I_IN) { p0_transpose_item(a.in[11], D, NIN, (bf16_t*)(ws + WS_WIN), 2, scr, r, F.lane); continue; } r -= I_IN;
            if (r < I_OUT) { p0_transpose_item(a.in[22], D, D, (bf16_t*)(ws + WS_WOUT), 0, scr, r, F.lane); continue; } r -= I_OUT;
            if (r < I_GU) { p0_transpose_item(a.in[23], D, 2 * FF, (bf16_t*)(ws + WS_WGU2), 1, scr, r, F.lane); continue; } r -= I_GU;
            p0_transpose_item(a.in[24], FF, D, (bf16_t*)(ws + WS_WD2), 0, scr, r, F.lane);
        }
    }
}
__device__ __forceinline__ void adaln_units(Frame& F, const Args& a, int j0, int j1, int gi, int gn) {
    float* mod = (float*)(a.ws + WS_MOD);
    LAS float* s = (LAS float*)(F.lds + RING_OFF);
    LAS float* part = (LAS float*)(F.lds + RING_OFF + 9 * D * 4);
    const float* c = a.in[1]; const float* c_ctx = a.in[3]; const float* w_ada = a.in[4]; const float* b_ada = a.in[5];
    __syncthreads();
    for (int idx = F.tid; idx < 9 * D; idx += NWAVES * 64) { const int r = idx >> 10, k = idx & (D - 1); const float v = r < NB ? c[r * D + k] : c_ctx[k]; s[idx] = v / (1.f + __expf(-v)); }
    __syncthreads();
    for (int j = j0 + gi; j < j1; j += gn) {
        const int cg = F.tid & 7, ks = F.tid >> 3;
        f32x4 acc[9];
#pragma unroll
        for (int r = 0; r < 9; ++r) acc[r] = (f32x4){0.f, 0.f, 0.f, 0.f};
#pragma unroll 4
        for (int kk = 0; kk < 16; ++kk) { const int k = ks * 16 + kk; const f32x4 w = *(const f32x4*)(w_ada + (size_t)k * (NMOD * D) + 32 * j + 4 * cg);
#pragma unroll
            for (int r = 0; r < 9; ++r) acc[r] += w * s[r * D + k]; }
#pragma unroll
        for (int r = 0; r < 9; ++r) *(LAS f32x4*)(part + (ks * 9 + r) * 32 + 4 * cg) = acc[r];
        __syncthreads();
        if (F.tid < 288) { const int r = F.tid >> 5, col = F.tid & 31; float sum = 0.f;
#pragma unroll 8
            for (int q = 0; q < 64; ++q) sum += part[(q * 9 + r) * 32 + col];
            mod[r * (NMOD * D) + 32 * j + col] = sum + b_ada[32 * j + col]; }
        __syncthreads();
    }
}
constexpr int ADA_EARLY = 2 * D / 32;
__device__ __forceinline__ void p0_prologue(Frame& F, const Args& a) {
    unsigned char* ws = a.ws;
    float* misc = (float*)(ws + WS_MISC);
    adaln_units(F, a, 0, ADA_EARLY, F.vcu, F.G);
    if (F.vcu == 0) {
        for (int e = F.tid; e < 1024; e += NWAVES * 64) { const int pos = e >> 4, i = e & 15; const float ang = (float)pos * powf(10000.f, -(float)i / 16.f); misc[e] = cosf(ang); misc[1024 + e] = sinf(ang); }
        if (F.tid < 64) { misc[2112 + F.tid] = a.in[12][F.tid]; misc[2176 + F.tid] = a.in[13][F.tid]; misc[2240 + F.tid] = a.in[19][F.tid]; misc[2304 + F.tid] = a.in[20][F.tid]; }
        if (F.tid == 0) { float x1 = 0.f, x2 = 0.f; for (int d = 0; d < 64; ++d) { x1 += a.in[14][d] * a.in[15][d]; x2 += a.in[16][d] * a.in[17][d]; } misc[2048] = expf(x1) - expf(x2) + LAM_INIT; }
    }
    __syncthreads();
    weight_copies(F, a, 0, F.vcu * NWAVES + F.wave, F.G * NWAVES);
}
template <int ST  >
__device__ __forceinline__ void normmod_phase(Frame& F, const void* lat, const float* ctx, const float* part  , int nrows, const float* gain, const float* mod, int shift_i, int scale_i, bf16_t* XN) {
    const int gw = F.vcu * NWAVES + F.wave, NGW = F.G * NWAVES, lane = F.lane;
    for (int row = gw; row < nrows; row += NGW) {
        const bool isl = row < ML; const int b = isl ? row / SEQ : NB;
        const float* sh = mod + b * (NMOD * D) + shift_i * D; const float* sc = mod + b * (NMOD * D) + scale_i * D;
        f32x4 v[4]; float ss = 0.f;
#pragma unroll
        for (int j = 0; j < 4; ++j) {
            if (!isl) { const size_t o2 = (size_t)(row - ML) * D + j * 256 + lane * 4; v[j] = *(const f32x4*)(ctx + o2);
                if (part) v[j] += (*(const f32x4*)(part + o2) + *(const f32x4*)(part + (size_t)MC * D + o2)) * (*(const f32x4*)(mod + NB * (NMOD * D) + 2 * D + j * 256 + lane * 4) * 0.5f); }
            else if (ST == 0) v[j] = *(const f32x4*)((const float*)lat + (size_t)row * D + j * 256 + lane * 4);
            else v[j] = __builtin_convertvector(*(const pg8::f16x4*)((const _Float16*)lat + (size_t)row * D + j * 256 + lane * 4), f32x4);
            const f32x4 q = v[j] * v[j]; ss += (q[0] + q[1]) + (q[2] + q[3]); }
        const float rstd = rsqrtf(wave_sum(ss) * (1.f / D) + EPS);
#pragma unroll
        for (int j = 0; j < 4; ++j) {
            const int col = j * 256 + lane * 4;
            const f32x4 g = *(const f32x4*)(gain + col), s4 = *(const f32x4*)(sh + col), c4 = *(const f32x4*)(sc + col);
            const f32x4 o = v[j] * rstd * g * (c4 + 1.f) + s4;
            unsigned long long w = (unsigned long long)pk2(o[0], o[1]) | ((unsigned long long)pk2(o[2], o[3]) << 32);
            *(unsigned long long*)(XN + (size_t)row * D + col) = w;
        }
    }
}
__device__ __forceinline__ void combine_phase(Frame& F, const bf16_t* OD, const float* gain, const float* misc, bf16_t* AO) {
    const int gw = F.vcu * NWAVES + F.wave, NGW = F.G * NWAVES, lane = F.lane; const float lam = misc[2048];
    const float g0 = gain[lane * 2], g1 = gain[lane * 2 + 1];
    for (int w = gw; w < ML * 4; w += NGW) {
        const int row = w >> 2, h = w & 3;
        const unsigned a = *(const unsigned*)(OD + (size_t)row * D + h * 256 + lane * 2), b = *(const unsigned*)(OD + (size_t)row * D + h * 256 + 128 + lane * 2);
        const float d0 = __uint_as_float(a << 16) - lam * __uint_as_float(b << 16), d1 = __uint_as_float(a & 0xffff0000u) - lam * __uint_as_float(b & 0xffff0000u);
        const float rstd = rsqrtf(wave_sum(d0 * d0 + d1 * d1) * (1.f / 128.f) + EPS) * (1.f - LAM_INIT);
        *(unsigned*)(AO + (size_t)row * D + h * 128 + lane * 2) = pk2(d0 * rstd * g0, d1 * rstd * g1);
    }
}
__device__ __forceinline__ void attention_phase(Frame& F, unsigned char* ldsg, const bf16_t* Yb, bf16_t* ODb, bf16_t* AOb, const float* rpb, const float* gain, const float* misc) {
    using attn_body::bf16;
    const bf16* Y = (const bf16*)Yb; bf16* OD = (bf16*)ODb; bf16* AO = (bf16*)AOb;
    for (int ug = F.vcu; ug < 256; ug += F.G) {
        const int b = ug >> 5, h = (ug >> 3) & 3, qb = ug & 7;
        const long qrow = (long)b * SEQ + qb * 256;
        for (int c = 0; c < 2; ++c)
            attn_body::attn_unit<0, 8, 128>(Y + qrow * NIN + h * 128 + c * 64, Y + 512 + h * 128 + c * 64, Y + 1024 + h * 128, ML + b * CTX, b * SEQ, 36,
                                            OD + qrow * D + h * 256 + c * 128, 0, 0, nullptr, (char*)ldsg);
        asm volatile("s_waitcnt vmcnt(0)" ::: "memory"); __syncthreads();
        const float lam = misc[2048]; const int lane = F.lane; const float g0 = gain[lane * 2], g1 = gain[lane * 2 + 1];
        for (int r = 0; r < 32; ++r) {
            const long row = qrow + F.wave * 32 + r;
            const unsigned a = *(const unsigned*)(ODb + row * D + h * 256 + lane * 2), bb = *(const unsigned*)(ODb + row * D + h * 256 + 128 + lane * 2);
            const float d0 = __uint_as_float(a << 16) - lam * __uint_as_float(bb << 16), d1 = __uint_as_float(a & 0xffff0000u) - lam * __uint_as_float(bb & 0xffff0000u);
            const float rstd = rsqrtf(wave_sum(d0 * d0 + d1 * d1) * (1.f / 128.f) + EPS) * (1.f - LAM_INIT);
            *(unsigned*)(AOb + row * D + h * 128 + lane * 2) = pk2(d0 * rstd * g0, d1 * rstd * g1);
        }
    }
    const int ngrp = F.G >> 2, grp0 = F.vcu >> 2, j = F.vcu & 3;
    for (int grp = grp0; grp < 64; grp += ngrp) {
        const int b = grp >> 3, h = grp & 7;
        for (int i = 0; i < 2; ++i) { const int uq = j + 4 * i;
            const int kr0 = (uq == 0) ? 0 : (uq == 7 ? 24 : 4 * uq - 4), nrow = (uq == 0 || uq == 7) ? 8 : 12;
            const long qrow = (long)b * SEQ + uq * 256;
            attn_body::attn_unit<1, 8, 64>(Y + qrow * NIN + 1536 + h * 64, Y + 2048 + h * 64, Y + 2560 + h * 64, ML + b * CTX, b * SEQ + 64 * kr0, 4 + nrow,
                                       AO + qrow * D + 512 + h * 64, 4 * uq, kr0, rpb + h * 465, (char*)ldsg); }
    }
}

__global__ void __launch_bounds__(NWAVES * 64, 2) mk_fwd(Args args) {
    extern __shared__ __attribute__((aligned(16))) unsigned char lds[];
    Frame F;
    F.lds = (LAS unsigned char*)lds;
    F.MISC = (volatile LAS unsigned*)(F.lds + MISC_OFF);
    F.tid = threadIdx.x; F.lane = F.tid & 63; F.wave = __builtin_amdgcn_readfirstlane(F.tid >> 6);
    F.G = gridDim.x; { const int bx = blockIdx.x; F.vcu = (F.G % 8 == 0) ? (bx % 8) * (F.G / 8) + bx / 8 : bx; }
    unsigned char* ws = args.ws;
    F.ctl = (gu32*)(ws + WS_CTL);
    for (int u = F.tid; u < (LDS_BYTES - LDSCTL_OFF) / 4; u += NWAVES * 64) ((LAS unsigned*)(F.lds + LDSCTL_OFF))[u] = 0u;
    __syncthreads();
    XcdBarrier bar = xcd_barrier_post((unsigned*)(F.ctl + CW_BAR) + args.li * XCD_BAR_WORDS, F.MISC + 8);
    const int lo = args.ph_lo, hi = args.ph_hi;
#ifndef PHMASK
#define PHMASK 0xFFF
#endif
#define IN(k) (((PHMASK >> (k)) & 1) && lo <= (k) && (k) < hi)
#ifndef REPMASK
#define REPMASK 0
#endif
#define REP(k) for (int rep_ = 0; rep_ < (((REPMASK >> (k)) & 1) ? 2 : 1); ++rep_)
#ifndef BARX
#define BARX 1
#endif
#define SEAM(k) do { if (IN(k) && IN((k) + 1)) { for (int bx_ = 0; bx_ < BARX; ++bx_) xcd_barrier(bar); } } while (0)
    float* out = args.out;
    float* mod = (float*)(ws + WS_MOD); float* misc = (float*)(ws + WS_MISC);
    bf16_t* XN = (bf16_t*)(ws + WS_XN); bf16_t* AO = XN;
    bf16_t* H = (bf16_t*)(ws + WS_BIG); bf16_t* Y = (bf16_t*)(ws + WS_BIG); bf16_t* OD = (bf16_t*)(ws + WS_OD);
    const float* x = args.in[0]; const float* ctx = args.in[2];
    float* part = (float*)(ws + WS_PART);
    _Float16* h1 = (_Float16*)out;
    _Float16* h2 = (_Float16*)(ws + WS_OD);

    if (IN(0)) REP(0) { p0_prologue(F, args); } SEAM(0);
    if (IN(1)) REP(1) { normmod_phase<0>(F, x, ctx, nullptr, MA, args.in[6], mod, 0, 1, XN); } SEAM(1);
    if (IN(2)) REP(2) { pg8::Gemm g{XN, (const bf16_t*)(ws + WS_WGU1), MA, 2 * FF, D}; pg8::StaticOrder S; S.init(MA, 2 * FF, F.G, (int)blockIdx.x); pg8::EpiGU E{H, pg8::mk_rsrc(H, (size_t)MA * FF * 2)};
        pg8::gemm_phase<pg8::EpiGU, pg8::StaticOrder, true, true>(F.lds + RING_OFF, g, S, E);
        { const int nb = (MA / 256) * (2 * FF / 256) % F.G; const int gi = nb > 0 ? (int)blockIdx.x - nb : F.vcu, gn = nb > 0 ? F.G - nb : F.G;
          if (gi >= 0) { adaln_units(F, args, ADA_EARLY, NMOD * D / 32, gi, gn); __syncthreads(); weight_copies(F, args, 2, gi * NWAVES + F.wave, gn * NWAVES); } } } SEAM(2);
    if (IN(3)) REP(3) { pg8::Gemm g{H, (const bf16_t*)(ws + WS_WD1), MA, D, FF}; pg8::Phase3Order S; S.init(F.G, (int)blockIdx.x); pg8::EpiRes<0, 1> E{x, nullptr, h1, part, mod, 2, 0.5f, pg8::mk_rsrc(part, (size_t)2 * MC * D * 4)};
        pg8::gemm_phase<pg8::EpiRes<0, 1>, pg8::Phase3Order, true, true>(F.lds + RING_OFF, g, S, E);
        { const int nbusy = 320 % F.G; if (nbusy > 0) { if ((int)blockIdx.x >= nbusy) weight_copies(F, args, 1, ((int)blockIdx.x - nbusy) * NWAVES + F.wave, (F.G - nbusy) * NWAVES); }
          else weight_copies(F, args, 1, F.vcu * NWAVES + F.wave, F.G * NWAVES); } } SEAM(3);
    if (IN(4)) REP(4) { normmod_phase<1>(F, h1, ctx, part, MA, args.in[7], mod, 3, 4, XN); } SEAM(4);
    if (IN(5)) REP(5) { pg8::Gemm g{XN, (const bf16_t*)(ws + WS_WIN), MA, NIN, D}; pg8::StaticOrder S; S.init(MA, NIN, F.G, (int)blockIdx.x);
        { LAS float* tab = (LAS float*)(F.lds + TAB_OFF); for (int i = F.tid; i < TAB_FLOATS; i += NWAVES * 64) tab[i] = misc[i < 2048 ? i : 64 + i]; __syncthreads(); }
        pg8::EpiIn E{Y, pg8::mk_rsrc(Y, (size_t)MA * NIN * 2), (const LAS float*)(F.lds + TAB_OFF)};
        pg8::gemm_phase<pg8::EpiIn, pg8::StaticOrder, true, true>(F.lds + RING_OFF, g, S, E); } SEAM(5);
    if (IN(6)) REP(6) { attention_phase(F, lds + RING_OFF, Y, OD, AO, args.in[21], args.in[18], misc); }
    if (IN(6) && (IN(7) || IN(8))) xcd_barrier(bar);
    if (IN(8)) REP(8) { pg8::Gemm g{AO, (const bf16_t*)(ws + WS_WOUT), ML, D, D}; pg8::StaticOrder S; S.init(ML, D, F.G, (int)blockIdx.x); pg8::EpiRes<1, 1> E{h1, nullptr, h2, nullptr, mod, 5, 1.f, pg8::mk_rsrc(part, 16)};
        pg8::gemm_phase<pg8::EpiRes<1, 1>, pg8::StaticOrder, true, true>(F.lds + RING_OFF, g, S, E); } SEAM(8);
    if (IN(9)) REP(9) { normmod_phase<1>(F, h2, ctx, nullptr, ML, args.in[8], mod, 6, 7, XN); } SEAM(9);
    if (IN(10)) REP(10) { pg8::Gemm g{XN, (const bf16_t*)(ws + WS_WGU2), ML, 2 * FF, D}; pg8::StaticOrder S; S.init(ML, 2 * FF, F.G, (int)blockIdx.x); pg8::EpiGU E{H, pg8::mk_rsrc(H, (size_t)ML * FF * 2)};
        pg8::gemm_phase<pg8::EpiGU, pg8::StaticOrder, true, true>(F.lds + RING_OFF, g, S, E); } SEAM(10);
    if (IN(11)) REP(11) { pg8::Gemm g{H, (const bf16_t*)(ws + WS_WD2), ML, D, FF}; pg8::StaticOrder S; S.init(ML, D, F.G, (int)blockIdx.x); pg8::EpiRes<1, 0> E{h2, nullptr, out, nullptr, mod, 8, 0.5f, pg8::mk_rsrc(part, 16)};
        pg8::gemm_phase<pg8::EpiRes<1, 0>, pg8::StaticOrder, true, true>(F.lds + RING_OFF, g, S, E); }
#undef IN
#undef SEAM
}

extern "C" void kernel_launch(void* const* d_in, const int* in_sizes, int n_in, void* d_out, int out_size, void* d_ws, size_t ws_size, hipStream_t stream) {
    static int grid = 0;
    if (grid == 0) {
        if (n_in != 25 || out_size != ML * D || ws_size < WS_END) { fprintf(stderr, "kernel_launch: unexpected shapes n_in %d out %d ws %zu\n", n_in, out_size, ws_size); grid = -1; return; }
        int dev = 0, cus = 0, per_cu = 0;
        if (hipGetDevice(&dev) != hipSuccess || hipDeviceGetAttribute(&cus, hipDeviceAttributeMultiprocessorCount, dev) != hipSuccess) { grid = -1; return; }
        if (hipFuncSetAttribute((const void*)mk_fwd, hipFuncAttributeMaxDynamicSharedMemorySize, LDS_BYTES) != hipSuccess) { fprintf(stderr, "kernel_launch: hipFuncSetAttribute failed\n"); grid = -1; return; }
        if (hipOccupancyMaxActiveBlocksPerMultiprocessor(&per_cu, (const void*)mk_fwd, NWAVES * 64, LDS_BYTES) != hipSuccess || per_cu < 1) { fprintf(stderr, "kernel_launch: occupancy query says %d blocks per CU\n", per_cu); (void)hipGetLastError(); grid = -1; return; }
        grid = cus;
    }
    if (grid < 0) return;
    (void)hipMemsetAsync((unsigned char*)d_ws + WS_CTL, 0, CTL_ZERO_BYTES, stream);
    Args a{};
    for (int i = 0; i < 25; ++i) a.in[i] = (const float*)d_in[i];
    a.out = (float*)d_out; a.ws = (unsigned char*)d_ws; a.ph_lo = 0; a.ph_hi = N_PHASES; a.li = 0; a.flags = 0;
#ifndef PROBE_PHASE
#define PROBE_PHASE -1
#endif
    if (PROBE_PHASE < 0) hipLaunchKernelGGL(mk_fwd, dim3(grid), dim3(NWAVES * 64), LDS_BYTES, stream, a);
    else {
        a.ph_lo = 0; a.ph_hi = PROBE_PHASE + 1; a.li = 0; hipLaunchKernelGGL(mk_fwd, dim3(grid), dim3(NWAVES * 64), LDS_BYTES, stream, a);
        a.ph_lo = PROBE_PHASE; a.ph_hi = PROBE_PHASE + 1; a.li = 1; hipLaunchKernelGGL(mk_fwd, dim3(grid), dim3(NWAVES * 64), LDS_BYTES, stream, a);
        if (PROBE_PHASE + 1 < N_PHASES) { a.ph_lo = PROBE_PHASE + 1; a.ph_hi = N_PHASES; a.li = 2; hipLaunchKernelGGL(mk_fwd, dim3(grid), dim3(NWAVES * 64), LDS_BYTES, stream, a); }
    }
}
```

```cpp
#include <hip/hip_runtime.h>
#include <hip/hip_bf16.h>
#include <cstdio>
#include <cstdint>
#include <cmath>

typedef unsigned short bf16_t;
__device__ __forceinline__ float bf2f(bf16_t v) { return __uint_as_float((unsigned)v << 16); }
__device__ __forceinline__ bf16_t f2bf(float f) { unsigned u = __float_as_uint(f); return (bf16_t)((u + 0x7fffu + ((u >> 16) & 1u)) >> 16); }

constexpr int D = 1024, NB = 8, SEQ = 2048, CTX = 256, FF = 2816, NIN = 3072, NMOD = 9;
constexpr int ML = NB * SEQ;
constexpr int MC = NB * CTX;
constexpr int MA = ML + MC;
constexpr float EPS = 1e-6f;
constexpr float LOG2E = 1.4426950408889634f;
constexpr float C2 = 0.125f * LOG2E;
constexpr float LAM_INIT = 0.2f;

constexpr size_t MiB = 1u << 20;
constexpr size_t WS_CTL = 0, CTL_ZERO_BYTES = 128 * 1024;
constexpr size_t WS_MOD = 1 * MiB;
constexpr size_t WS_MISC = 1 * MiB + 512 * 1024;
constexpr size_t WS_WGU1 = 2 * MiB, WS_WD1 = 13 * MiB, WS_WIN = 19 * MiB, WS_WOUT = 25 * MiB, WS_WGU2 = 27 * MiB, WS_WD2 = 38 * MiB;
constexpr size_t WS_XN = 44 * MiB;
constexpr size_t WS_H1C = 80 * MiB;
constexpr size_t WS_BIG = 88 * MiB;
constexpr size_t WS_OD = WS_BIG + (size_t)MA * NIN * 2;
constexpr size_t WS_PART = WS_OD + (size_t)ML * D * 2;
constexpr size_t WS_END = WS_PART + (size_t)2 * MC * D * 4;
static_assert(WS_WD2 + (size_t)D * FF * 2 <= WS_XN && WS_XN + (size_t)MA * D * 2 <= WS_H1C && WS_H1C + (size_t)MC * D * 4 <= WS_BIG && WS_END <= 256 * MiB, "workspace");

namespace pg8 {
#define PG8_LAS __attribute__((address_space(3)))
typedef unsigned short bf16_t;
typedef short bf16x8 __attribute__((ext_vector_type(8)));
typedef float f32x4 __attribute__((ext_vector_type(4)));
typedef unsigned u32x4 __attribute__((ext_vector_type(4)));
typedef unsigned u32x2 __attribute__((ext_vector_type(2)));
constexpr int BM = 256, BK = 64, HALF = 128, HTB = HALF * BK * 2  , STAGE_BYTES = 8 * HTB, NXCD = 8, WGM = 8;

__host__ __device__ __forceinline__ int lds_byte(int r, int c) { const int st = (r >> 4) * 2 + (c >> 5), rr = r & 15, cc = c & 31, ob = rr * 64 + cc * 2; return st * 1024 + (ob ^ (((ob >> 9) & 1) << 5)); }
__host__ __device__ __forceinline__ void stage_rc(int b, int& R, int& C) { const int st = b / 1024, sb = b % 1024, swz = sb ^ (((sb >> 9) & 1) << 5); R = (st >> 1) * 16 + swz / 64; C = (st & 1) * 32 + (swz % 64) / 2; }
__host__ __device__ __forceinline__ int perm32(int rho) { const int n = rho >> 4, i = rho & 15; return 8 * (i >> 2) + 4 * n + (i & 3); }

struct Unit { int pm, pn, kofs, nt; };
struct Gemm { const bf16_t* A; const bf16_t* Bt; int M, N, K; };

struct StaticOrder {
    int nM, nN, nwg, G, c;
    __host__ __device__ void init(int M, int N, int G_, int c_) { nM = M / BM; nN = N / BM; nwg = nM * nN; G = G_; c = c_; }
    __host__ __device__ bool next(int i, Unit& u) const { return at((long)i * G + c, u); }
    __host__ __device__ bool at(long L, Unit& u) const {
        if (L >= nwg) return false;
        int wgid = (int)L; { const int q = nwg / NXCD, r = nwg % NXCD, xcd = wgid % NXCD, off = wgid / NXCD; wgid = (xcd < r ? xcd * (q + 1) : r * (q + 1) + (xcd - r) * q) + off; }
        const int nig = WGM * nN, gid = wgid / nig, fm = gid * WGM, gsz = (nM - fm) < WGM ? (nM - fm) : WGM;
        u.pm = fm + ((wgid % nig) % gsz); u.pn = (wgid % nig) / gsz; u.kofs = 0; u.nt = 0; return true;
    }
    __device__ __forceinline__ void a_ready(const Unit&) const {}
    __device__ __forceinline__ void done(const Unit&) const {}
};

__device__ __forceinline__ unsigned cvt_pk_bf16(float lo, float hi) { unsigned r; asm volatile("v_cvt_pk_bf16_f32 %0, %1, %2" : "=v"(r) : "v"(lo), "v"(hi)); return r; }

struct Phase3Order {
    StaticOrder lat; int c, G;
    __host__ __device__ void init(int G_, int c_) { lat.init(ML, D, G_, c_); c = c_; G = G_; }
    __host__ __device__ bool next(int i, Unit& u) const {
        const long L = (long)i * G + c;
        if (L < ML / BM * (D / BM)) return lat.at(L, u);
        const int q = (int)(L - ML / BM * (D / BM)); if (q >= 64) return false;
        const int j = q >> 3; u.pm = ML / BM + (q & 7); u.pn = j >> 1; u.kofs = (j & 1) * (FF / 2); u.nt = FF / 2 / BK; return true;
    }
    __device__ __forceinline__ void a_ready(const Unit&) const {}
    __device__ __forceinline__ void done(const Unit&) const {}
};

#ifndef WT_STORES
#define WT_STORES 0
#endif
__device__ __forceinline__ __amdgpu_buffer_rsrc_t mk_rsrc(const void* p, size_t bytes) { return __builtin_amdgcn_make_buffer_rsrc((void*)p, (short)0, (int)bytes, 0x00020000); }
__device__ __forceinline__ void st16(__amdgpu_buffer_rsrc_t r, void* base, size_t byte_off, u32x4 v) {
    if (WT_STORES) __builtin_amdgcn_raw_buffer_store_b128(v, r, (unsigned)byte_off, 0, 16); else *(u32x4*)((char*)base + byte_off) = v; }
__device__ __forceinline__ float silu_f(float x) { return x * __builtin_amdgcn_rcpf(1.f + __builtin_amdgcn_exp2f(-x * LOG2E)); }
struct EpiGU {
    static constexpr bool PERM = false, AFTER_DRAIN = false;
    bf16_t* H; __amdgpu_buffer_rsrc_t Hr;
    __device__ __forceinline__ void operator()(const f32x4 (&acc)[2][2][4][2], const Unit& u, int wr, int wc, int fr, int fq) const {
        const int row0 = u.pm * BM + wr * 64 + fr, col0 = u.pn * HALF + wc * 32 + 8 * fq;
#pragma unroll
        for (int ai = 0; ai < 2; ++ai)
#pragma unroll
            for (int m = 0; m < 4; ++m) {
                const f32x4 g0 = acc[ai][0][m][0], g1 = acc[ai][0][m][1], u0 = acc[ai][1][m][0], u1 = acc[ai][1][m][1];
                u32x4 w;
                w.x = cvt_pk_bf16(silu_f(g0[0]) * u0[0], silu_f(g0[1]) * u0[1]); w.y = cvt_pk_bf16(silu_f(g0[2]) * u0[2], silu_f(g0[3]) * u0[3]);
                w.z = cvt_pk_bf16(silu_f(g1[0]) * u1[0], silu_f(g1[1]) * u1[1]); w.w = cvt_pk_bf16(silu_f(g1[2]) * u1[2], silu_f(g1[3]) * u1[3]);
                st16(Hr, H, ((size_t)(row0 + ai * HALF + m * 16) * FF + col0) * 2, w);
            }
    }
};
typedef _Float16 f16x4 __attribute__((ext_vector_type(4)));
template <int BT, int OT>
struct EpiRes {
    static constexpr bool PERM = false, AFTER_DRAIN = false;
    const void* base_lat; const float* base_ctx; void* out_lat; float* out_ctx; const float* mod; int mi; float coef; __amdgpu_buffer_rsrc_t pr;
    __device__ __forceinline__ void operator()(const f32x4 (&acc)[2][2][4][2], const Unit& u, int wr, int wc, int fr, int fq) const {
        const bool isl = u.pm < ML / BM; const int b = isl ? (u.pm >> 3) : NB; const int rowt = (isl ? u.pm : u.pm - ML / BM) * BM;
        const int col0 = u.pn * BM + wc * 32 + 4 * fq;
        f32x4 mv[2][2];
#pragma unroll
        for (int bj = 0; bj < 2; ++bj)
#pragma unroll
            for (int n = 0; n < 2; ++n) mv[bj][n] = *(const f32x4*)(mod + b * (NMOD * D) + mi * D + col0 + bj * HALF + n * 16) * coef;
        if (isl) {
#pragma unroll
            for (int ai = 0; ai < 2; ++ai)
#pragma unroll
                for (int m = 0; m < 4; ++m) { const size_t off = (size_t)(rowt + ai * HALF + wr * 64 + m * 16 + fr) * D + col0;
#pragma unroll
                    for (int bj = 0; bj < 2; ++bj)
#pragma unroll
                        for (int n = 0; n < 2; ++n) { const size_t o2 = off + bj * HALF + n * 16; f32x4 bs;
                            if (BT == 0) bs = *(const f32x4*)((const float*)base_lat + o2); else bs = __builtin_convertvector(*(const f16x4*)((const _Float16*)base_lat + o2), f32x4);
                            const f32x4 o = bs + mv[bj][n] * acc[ai][bj][m][n];
                            if (OT == 0) *(f32x4*)((float*)out_lat + o2) = o; else *(f16x4*)((_Float16*)out_lat + o2) = __builtin_convertvector(o, f16x4); }
                    if (BT == 1 ? (m == 3) : (m & 1)) asm volatile("" ::: "memory"); }
        } else {
            const size_t obase = ((size_t)(u.kofs ? MC : 0) * D + (size_t)rowt * D) * 4;
#pragma unroll
            for (int ai = 0; ai < 2; ++ai)
#pragma unroll
                for (int m = 0; m < 4; ++m) { const size_t off = (size_t)(ai * HALF + wr * 64 + m * 16 + fr) * D + col0;
#pragma unroll
                    for (int bj = 0; bj < 2; ++bj)
#pragma unroll
                        for (int n = 0; n < 2; ++n) st16(pr, out_ctx, obase + (off + bj * HALF + n * 16) * 4, __builtin_bit_cast(u32x4, acc[ai][bj][m][n])); }
        }
    }
};
struct EpiIn {
    static constexpr bool PERM = false, AFTER_DRAIN = false;
    bf16_t* Y; __amdgpu_buffer_rsrc_t Yr; const PG8_LAS float* tab;
    __device__ __forceinline__ void operator()(const f32x4 (&acc)[2][2][4][2], const Unit& u, int wr, int wc, int fr, int fq) const {
        const int grp = u.pn >> 1, row0 = u.pm * BM + wr * 64 + fr;
        if (grp == 2 || grp == 5) {
            const int col0 = u.pn * BM + wc * 32 + 8 * fq;
#pragma unroll
            for (int ai = 0; ai < 2; ++ai)
#pragma unroll
                for (int m = 0; m < 4; ++m) { const size_t rowo = ((size_t)(row0 + ai * HALF + m * 16) * NIN + col0) * 2;
#pragma unroll
                    for (int bj = 0; bj < 2; ++bj) { const f32x4 v0 = acc[ai][bj][m][0], v1 = acc[ai][bj][m][1]; u32x4 w;
                        w.x = cvt_pk_bf16(v0[0], v0[1]); w.y = cvt_pk_bf16(v0[2], v0[3]); w.z = cvt_pk_bf16(v1[0], v1[1]); w.w = cvt_pk_bf16(v1[2], v1[3]);
                        st16(Yr, Y, rowo + bj * HALF * 2, w); } }
        } else {
            const int hq = fq >> 1, i0 = 8 * (fq & 1);
            const PG8_LAS float* gain = tab + 2048 + 64 * (grp - (grp > 2 ? 1 : 0)) + 32 * hq + i0;
            const float sc = (grp == 0 || grp == 3) ? C2 : 1.f;
            const bool dorope = grp < 2 && u.pm < ML / BM;
            f32x4 gv[2][2];
#pragma unroll
            for (int bj = 0; bj < 2; ++bj)
#pragma unroll
                for (int n = 0; n < 2; ++n) gv[bj][n] = *(const PG8_LAS f32x4*)(gain + 16 * bj + 4 * n);
            const int col0 = u.pn * BM + wc * 64 + 32 * hq + i0;
#pragma unroll
            for (int ai = 0; ai < 2; ++ai)
#pragma unroll
                for (int m = 0; m < 4; ++m) {
                    const int row = row0 + ai * HALF + m * 16;
                    f32x4 v[2][2]; float ss = 0.f;
#pragma unroll
                    for (int bj = 0; bj < 2; ++bj)
#pragma unroll
                        for (int n = 0; n < 2; ++n) { v[bj][n] = acc[ai][bj][m][n]; const f32x4 q = v[bj][n] * v[bj][n]; ss += (q[0] + q[1]) + (q[2] + q[3]); }
                    ss += __shfl_xor(ss, 16); ss += __shfl_xor(ss, 32);
                    const float rstd = __builtin_amdgcn_rsqf(ss * (1.f / 64.f) + EPS);
#pragma unroll
                    for (int bj = 0; bj < 2; ++bj)
#pragma unroll
                        for (int n = 0; n < 2; ++n) v[bj][n] = v[bj][n] * rstd * gv[bj][n];
                    if (dorope) {
                        const int t = row & (SEQ - 1), pos = hq ? (t & 63) : (t >> 6);
#pragma unroll
                        for (int n = 0; n < 2; ++n) { const f32x4 cs = *(const PG8_LAS f32x4*)(tab + pos * 16 + i0 + 4 * n), sn = *(const PG8_LAS f32x4*)(tab + 1024 + pos * 16 + i0 + 4 * n);
                            const f32x4 a = v[0][n], b2 = v[1][n]; v[0][n] = a * cs - b2 * sn; v[1][n] = b2 * cs + a * sn; }
                    }
                    const size_t rowo = ((size_t)row * NIN + col0) * 2;
#pragma unroll
                    for (int bj = 0; bj < 2; ++bj) { const f32x4 o0 = v[bj][0] * sc, o1 = v[bj][1] * sc; u32x4 w;
                        w.x = cvt_pk_bf16(o0[0], o0[1]); w.y = cvt_pk_bf16(o0[2], o0[3]); w.z = cvt_pk_bf16(o1[0], o1[1]); w.w = cvt_pk_bf16(o1[2], o1[3]); st16(Yr, Y, rowo + 32 * bj, w); }
                }
        }
    }
};

template <class Epi, class Sched, bool ALIGN_EPI = false, bool SP2 = false>
__device__ __forceinline__ void gemm_phase(PG8_LAS unsigned char* lds, const Gemm g, const Sched& S, const Epi& E) {
    const int tid = threadIdx.x, wid = __builtin_amdgcn_readfirstlane(tid >> 6), lane = tid & 63, wr = wid >> 2, wc = wid & 3, fr = lane & 15, fq = lane >> 4;
    const int K = g.K, nt = K / BK;
    unsigned voffA[2], voffB[2];
#pragma unroll
    for (int i = 0; i < 2; ++i) { int R, C; stage_rc(tid * 16 + i * 8192, R, C); const int Rb = Epi::PERM ? ((R & ~31) + perm32(R & 31)) : R;
        voffA[i] = (unsigned)(R * K + C) * 2u; voffB[i] = (unsigned)(Rb * K + C) * 2u; }
    const size_t kstep = (size_t)(BK * 2);
    const size_t hstep = (size_t)HALF * K * 2;
    const size_t tstep = 2 * hstep;
    const unsigned ldsw = (unsigned)wid * 1024u;
    const int aoff = lds_byte(wr * 64 + fr, fq * 8), boff = lds_byte(wc * 32 + fr, fq * 8);
#define PG8_SA(b, h) (((b) * 2 + (h)) * HTB)
#define PG8_SB(b, h) ((4 + (b) * 2 + (h)) * HTB)
#define PG8_STAGE(bufoff, gbase, voff) do { _Pragma("unroll") for (int _i = 0; _i < 2; ++_i) \
        __builtin_amdgcn_global_load_lds((const unsigned*)((const char*)(gbase) + (voff)[_i]), (PG8_LAS unsigned*)(lds + (bufoff) + ldsw + _i * 8192), 16, 0, 0); } while (0)
#define PG8_LDA(dst, b, h) do { _Pragma("unroll") for (int m = 0; m < 4; ++m) _Pragma("unroll") for (int k = 0; k < 2; ++k) dst[m][k] = *(const PG8_LAS bf16x8*)(lds + PG8_SA(b, h) + aoff + m * 2048 + k * 1024); } while (0)
#define PG8_LDB(dst, b, h) do { _Pragma("unroll") for (int n = 0; n < 2; ++n) _Pragma("unroll") for (int k = 0; k < 2; ++k) dst[n][k] = *(const PG8_LAS bf16x8*)(lds + PG8_SB(b, h) + boff + n * 2048 + k * 1024); } while (0)
#define PG8_MMA(ai, bj, At, Bt) do { __builtin_amdgcn_s_setprio(1); _Pragma("unroll") for (int m = 0; m < 4; ++m) _Pragma("unroll") for (int n = 0; n < 2; ++n) _Pragma("unroll") for (int k = 0; k < 2; ++k) \
        acc[ai][bj][m][n] = __builtin_amdgcn_mfma_f32_16x16x32_bf16(Bt[n][k], At[m][k], acc[ai][bj][m][n], 0, 0, 0); __builtin_amdgcn_s_setprio(0); } while (0)
#define PG8_WAIT_V(n) asm volatile("s_waitcnt vmcnt(" #n ")" ::: "memory")
#define PG8_WAIT_L(n) asm volatile("s_waitcnt lgkmcnt(" #n ")" ::: "memory")
#define PG8_BAR __builtin_amdgcn_s_barrier()
#define PG8_SCHED __builtin_amdgcn_sched_barrier(0)
    Unit cur, nxt; int ui = 0;
    if (!S.next(0, cur)) return;
    f32x4 acc[2][2][4][2];
#pragma unroll
    for (int a = 0; a < 2; ++a)
#pragma unroll
        for (int b = 0; b < 2; ++b)
#pragma unroll
            for (int m = 0; m < 4; ++m)
#pragma unroll
                for (int n = 0; n < 2; ++n) acc[a][b][m][n] = (f32x4){0.f, 0.f, 0.f, 0.f};
    bf16x8 At[4][2], B0[2][2], B1[2][2];
    const char* cA = (const char*)g.A + (size_t)cur.pm * tstep + (size_t)cur.kofs * 2; const char* cB = (const char*)g.Bt + (size_t)cur.pn * tstep + (size_t)cur.kofs * 2;
    S.a_ready(cur);
    if constexpr (SP2) {
        PG8_STAGE(PG8_SB(0, 0), cB, voffB); PG8_STAGE(PG8_SB(0, 1), cB + hstep, voffB); PG8_STAGE(PG8_SA(0, 0), cA, voffA); PG8_STAGE(PG8_SA(0, 1), cA + hstep, voffA);
        if (wr == 1) PG8_BAR;
        PG8_WAIT_V(2); PG8_BAR;
        PG8_STAGE(PG8_SB(1, 0), cB + kstep, voffB); PG8_STAGE(PG8_SA(1, 0), cA + kstep, voffA); PG8_STAGE(PG8_SB(1, 1), cB + hstep + kstep, voffB);
        PG8_WAIT_V(6); PG8_BAR;
    } else {
        PG8_STAGE(PG8_SB(0, 0), cB, voffB); PG8_STAGE(PG8_SA(0, 0), cA, voffA); PG8_STAGE(PG8_SB(0, 1), cB + hstep, voffB); PG8_STAGE(PG8_SA(0, 1), cA + hstep, voffA);
        if (wr == 1) PG8_BAR;
        PG8_WAIT_V(4); PG8_BAR;
        PG8_STAGE(PG8_SB(1, 0), cB + kstep, voffB); PG8_STAGE(PG8_SA(1, 0), cA + kstep, voffA); PG8_STAGE(PG8_SB(1, 1), cB + hstep + kstep, voffB);
        PG8_WAIT_V(6); PG8_BAR;
    }
    for (;;) {
        const bool has_next = S.next(ui + 1, nxt);
        const char* nA = has_next ? (const char*)g.A + (size_t)nxt.pm * tstep + (size_t)nxt.kofs * 2 : cA; const char* nB = has_next ? (const char*)g.Bt + (size_t)nxt.pn * tstep + (size_t)nxt.kofs * 2 : cB;
        const int unt = cur.nt ? cur.nt : nt;
        for (int t = 0; t < unt; t += 2) {
            const bool last = (t == unt - 2);
            const char* a1 = cA + (size_t)(t + 1) * kstep;
            const char* a2 = last ? nA : cA + (size_t)(t + 2) * kstep; const char* b2 = last ? nB : cB + (size_t)(t + 2) * kstep;
            const char* a3 = a2 + kstep; const char* b3 = b2 + kstep;
            if (last && has_next) S.a_ready(nxt);
            if constexpr (SP2) {
            PG8_LDB(B0, 0, 0); PG8_LDB(B1, 0, 1); PG8_SCHED; PG8_LDA(At, 0, 0); PG8_STAGE(PG8_SA(1, 1), a1 + hstep, voffA);
            PG8_WAIT_V(8); PG8_WAIT_L(0); PG8_BAR; PG8_MMA(0, 0, At, B0); PG8_MMA(0, 1, At, B1); PG8_BAR; PG8_SCHED;
            PG8_LDA(At, 0, 1); PG8_STAGE(PG8_SB(0, 0), b2, voffB); PG8_STAGE(PG8_SB(0, 1), b2 + hstep, voffB); PG8_STAGE(PG8_SA(0, 0), a2, voffA);
            PG8_WAIT_V(8); PG8_WAIT_L(0); PG8_BAR; PG8_MMA(1, 0, At, B0); PG8_MMA(1, 1, At, B1); PG8_BAR; PG8_SCHED;
            PG8_LDB(B0, 1, 0); PG8_LDB(B1, 1, 1); PG8_SCHED; PG8_LDA(At, 1, 0); PG8_STAGE(PG8_SA(0, 1), a2 + hstep, voffA);
            PG8_WAIT_V(8); PG8_WAIT_L(0); PG8_BAR; PG8_MMA(0, 0, At, B0); PG8_MMA(0, 1, At, B1); PG8_BAR; PG8_SCHED;
            PG8_LDA(At, 1, 1); PG8_STAGE(PG8_SB(1, 0), b3, voffB); PG8_STAGE(PG8_SB(1, 1), b3 + hstep, voffB); PG8_STAGE(PG8_SA(1, 0), a3, voffA);
            PG8_WAIT_V(8); PG8_WAIT_L(0); PG8_BAR; PG8_MMA(1, 0, At, B0); PG8_MMA(1, 1, At, B1); PG8_BAR; PG8_SCHED;
            } else {
            PG8_LDB(B0, 0, 0); PG8_SCHED; PG8_LDA(At, 0, 0); PG8_STAGE(PG8_SA(1, 1), a1 + hstep, voffA);
            PG8_WAIT_L(8); PG8_BAR; PG8_WAIT_L(0); PG8_MMA(0, 0, At, B0); PG8_BAR; PG8_SCHED;
            PG8_LDB(B1, 0, 1); PG8_STAGE(PG8_SB(0, 0), b2, voffB);
            PG8_BAR; PG8_WAIT_L(0); PG8_MMA(0, 1, At, B1); PG8_BAR;
            PG8_LDA(At, 0, 1); PG8_STAGE(PG8_SA(0, 0), a2, voffA);
            PG8_BAR; PG8_WAIT_L(0); PG8_MMA(1, 0, At, B0); PG8_BAR; PG8_SCHED;
            PG8_STAGE(PG8_SB(0, 1), b2 + hstep, voffB);
            PG8_WAIT_V(6); PG8_BAR; PG8_MMA(1, 1, At, B1); PG8_BAR;
            PG8_LDB(B0, 1, 0); PG8_SCHED; PG8_LDA(At, 1, 0); PG8_STAGE(PG8_SA(0, 1), a2 + hstep, voffA);
            PG8_WAIT_L(8); PG8_BAR; PG8_WAIT_L(0); PG8_MMA(0, 0, At, B0); PG8_BAR; PG8_SCHED;
            PG8_LDB(B1, 1, 1); PG8_STAGE(PG8_SB(1, 0), b3, voffB);
            PG8_BAR; PG8_WAIT_L(0); PG8_MMA(0, 1, At, B1); PG8_BAR;
            PG8_LDA(At, 1, 1); PG8_STAGE(PG8_SA(1, 0), a3, voffA);
            PG8_BAR; PG8_WAIT_L(0); PG8_MMA(1, 0, At, B0); PG8_BAR; PG8_SCHED;
            PG8_STAGE(PG8_SB(1, 1), b3 + hstep, voffB);
            PG8_WAIT_V(6); PG8_BAR; PG8_MMA(1, 1, At, B1); PG8_BAR;
            }
        }
        if constexpr (ALIGN_EPI) { if (wr == 0) PG8_BAR; }
        if constexpr (!Epi::AFTER_DRAIN) { E(acc, cur, wr, wc, fr, fq); S.done(cur); }
        if (!has_next) break;
#pragma unroll
        for (int a = 0; a < 2; ++a)
#pragma unroll
            for (int b = 0; b < 2; ++b)
#pragma unroll
                for (int m = 0; m < 4; ++m)
#pragma unroll
                    for (int n = 0; n < 2; ++n) acc[a][b][m][n] = (f32x4){0.f, 0.f, 0.f, 0.f};
        cur = nxt; cA = nA; cB = nB; ++ui;
        if constexpr (ALIGN_EPI) { if (wr == 1) PG8_BAR; }
    }
    PG8_WAIT_V(0);
    if constexpr (!ALIGN_EPI) { if (wr == 0) PG8_BAR; }
    PG8_BAR;
    if constexpr (Epi::AFTER_DRAIN) { E.fused(acc, cur, wr, wc, fr, fq, lds, wid, lane); S.done(cur); }
#undef PG8_SA
#undef PG8_SB
#undef PG8_STAGE
#undef PG8_LDA
#undef PG8_LDB
#undef PG8_MMA
#undef PG8_WAIT_V
#undef PG8_WAIT_L
#undef PG8_BAR
#undef PG8_SCHED
}
}

#include <hip/hip_bf16.h>
namespace attn_body {
using bf16=__hip_bfloat16;
using bf16x8=__attribute__((ext_vector_type(8)))short;
using s16x4=__attribute__((ext_vector_type(4)))short;
using f32x16=__attribute__((ext_vector_type(16)))float;
using u32x4=__attribute__((ext_vector_type(4)))unsigned;
constexpr int D=64,PY=3072,PO=1024;
constexpr int NW=8,QBLK=32,QB=QBLK*NW,KVBLK=64;
__device__ __forceinline__ int crow(int r,int hi){return (r&3)+8*(r>>2)+4*hi;}
#define SBAR() __builtin_amdgcn_sched_barrier(0)
typedef __attribute__((address_space(3))) const float* lds_cfptr;
__device__ __forceinline__ void namask(f32x16&p0,f32x16&p1,bool rowok,int u0,lds_cfptr bl){
  const float NEG=-INFINITY;
  asm volatile("":"+v"(u0));
  if(!rowok){
    #pragma unroll
    for(int r=0;r<16;++r){p0[r]=NEG;p1[r]=NEG;}
  } else {
    #pragma unroll
    for(int g=0;g<4;++g){
      #pragma unroll
      for(int k=0;k<4;++k){const int r=4*g+k, cr=8*g+k;
        float b0=bl[cr], b1=bl[cr+32]; asm volatile("":"+v"(b0),"+v"(b1));
        p0[r]=((unsigned)(u0+cr)<16u)?p0[r]+b0:NEG; p1[r]=((unsigned)(u0+cr+32)<16u)?p1[r]+b1:NEG;}
      SBAR();
    }
  }
}


constexpr int NSLOT=3, SLOTB=8192, SLOTV=16384;
constexpr int LDS_K=0, LDS_V=NSLOT*SLOTB, LDS_WS=LDS_V+NSLOT*SLOTV, LDS_OST=LDS_WS+NW*64*4, LDS_RPB=LDS_OST+NW*4096, RPB_PAD=64, LDS_BYTES=LDS_RPB+640*4;
constexpr float C2=0.125f*1.4426950408889634f;
__device__ __forceinline__ void glds16(const void*gsrc,unsigned lds_dst){unsigned keep;
  asm volatile("s_mov_b32 %0, m0\n\ts_mov_b32 m0, %2\n\ts_nop 0\n\tglobal_load_lds_dwordx4 %1, off\n\ts_mov_b32 m0, %0":"=&s"(keep):"v"(gsrc),"s"(lds_dst):"memory");}
__device__ __forceinline__ float max3f(float a,float b,float c){float r;asm("v_max3_f32 %0, %1, %2, %3":"=v"(r):"v"(a),"v"(b),"v"(c));return r;}
__device__ __forceinline__ float max2f(float a,float b){float r;asm("v_max_f32_e32 %0, %1, %2":"=v"(r):"v"(a),"v"(b));return r;}
__device__ __forceinline__ float fadd_s(float a,float b){float r;asm("v_add_f32_e32 %0, %1, %2":"=v"(r):"v"(a),"v"(b));return r;}
__device__ __forceinline__ float fsub_s(float a,float b){float r;asm("v_sub_f32_e32 %0, %1, %2":"=v"(r):"v"(a),"v"(b));return r;}
typedef float f32x2_t __attribute__((ext_vector_type(2))); typedef __bf16 bf16x2_t __attribute__((ext_vector_type(2)));
__device__ __forceinline__ unsigned cvtpk_s(float lo,float hi){f32x2_t v={lo,hi};bf16x2_t b=__builtin_convertvector(v,bf16x2_t);return __builtin_bit_cast(unsigned,b);}
#define WAIT_BAR(N) asm volatile("s_waitcnt vmcnt(" #N ") lgkmcnt(0)\n\ts_barrier":::"memory")

__device__ __forceinline__ void qkt(f32x16&p0,f32x16&p1,const char*Kslot,const bf16x8*qr,const f32x16&negm,int r32,int hi){
  const char*kb=Kslot+hi*1024+r32*16;
  #pragma unroll
  for(int d0=0;d0<4;++d0){
    const bf16x8 b0=*reinterpret_cast<const bf16x8*>(kb+d0*2048);
    const bf16x8 b1=*reinterpret_cast<const bf16x8*>(kb+d0*2048+512);
    if(d0==0){p0=__builtin_amdgcn_mfma_f32_32x32x16_bf16(b0,qr[0],negm,0,0,0);p1=__builtin_amdgcn_mfma_f32_32x32x16_bf16(b1,qr[0],negm,0,0,0);}
    else{p0=__builtin_amdgcn_mfma_f32_32x32x16_bf16(b0,qr[d0],p0,0,0,0);p1=__builtin_amdgcn_mfma_f32_32x32x16_bf16(b1,qr[d0],p1,0,0,0);}}
}
typedef __attribute__((address_space(3))) const char* lds_cptr;
typedef short v4i16_t __attribute__((ext_vector_type(4)));
__device__ __forceinline__ void kload8(bf16x8*kf,lds_cptr kp){
  kf[0]=*(const __attribute__((address_space(3))) bf16x8*)(kp);      kf[1]=*(const __attribute__((address_space(3))) bf16x8*)(kp+512);
  kf[2]=*(const __attribute__((address_space(3))) bf16x8*)(kp+2048); kf[3]=*(const __attribute__((address_space(3))) bf16x8*)(kp+2560);
  kf[4]=*(const __attribute__((address_space(3))) bf16x8*)(kp+4096); kf[5]=*(const __attribute__((address_space(3))) bf16x8*)(kp+4608);
  kf[6]=*(const __attribute__((address_space(3))) bf16x8*)(kp+6144); kf[7]=*(const __attribute__((address_space(3))) bf16x8*)(kp+6656);
}
__device__ __forceinline__ void kload2(bf16x8*kf,lds_cptr kp,int j){ kf[2*j]=*(const __attribute__((address_space(3))) bf16x8*)(kp+j*2048); kf[2*j+1]=*(const __attribute__((address_space(3))) bf16x8*)(kp+j*2048+512); }
__device__ __forceinline__ s16x4 vtr(lds_cptr p){ return __builtin_bit_cast(s16x4,__builtin_amdgcn_ds_read_tr16_b64_v4i16((__attribute__((address_space(3))) v4i16_t*)p)); }
__device__ __forceinline__ float rowmax(const f32x16&p0,const f32x16&p1){
  float a=max3f(p0[0],p0[1],p1[0]),b=max3f(p0[2],p0[3],p1[1]);a=max3f(a,p1[2],p1[3]);
  #pragma unroll
  for(int r=4;r<16;r+=4){a=max3f(a,p0[r],p0[r+1]);b=max3f(b,p0[r+2],p0[r+3]);a=max3f(a,p1[r],p1[r+1]);b=max3f(b,p1[r+2],p1[r+3]);}
  const float m=max2f(a,b);
  auto rr=__builtin_amdgcn_permlane32_swap(__float_as_uint(m),__float_as_uint(m),false,false);
  return max2f(__uint_as_float(rr[0]),__uint_as_float(rr[1]));
}
template<int ND> __device__ __forceinline__ void pv(f32x16*o,int vb,bf16x8 pa0,bf16x8 pa1,bf16x8 pa2,bf16x8 pa3){
  #pragma unroll
  for(int d0=0;d0<ND;++d0){s16x4 lo[4],hi[4];
    #pragma unroll
    for(int ks=0;ks<4;++ks){
      asm volatile("ds_read_b64_tr_b16 %0,%1 offset:%c2":"=&v"(lo[ks]):"v"(vb),"i"(d0*4096+ks*1024):"memory");
      asm volatile("ds_read_b64_tr_b16 %0,%1 offset:%c2":"=&v"(hi[ks]):"v"(vb),"i"(d0*4096+ks*1024+512):"memory");}
    asm volatile("s_waitcnt lgkmcnt(0)":::"memory");SBAR();
    #define PK(k) (bf16x8){lo[k][0],lo[k][1],lo[k][2],lo[k][3],hi[k][0],hi[k][1],hi[k][2],hi[k][3]}
    o[d0]=__builtin_amdgcn_mfma_f32_32x32x16_bf16(pa0,PK(0),o[d0],0,0,0);
    o[d0]=__builtin_amdgcn_mfma_f32_32x32x16_bf16(pa1,PK(1),o[d0],0,0,0);
    o[d0]=__builtin_amdgcn_mfma_f32_32x32x16_bf16(pa2,PK(2),o[d0],0,0,0);
    o[d0]=__builtin_amdgcn_mfma_f32_32x32x16_bf16(pa3,PK(3),o[d0],0,0,0);
    #undef PK
  }
}

#ifndef ATTN_STORE16
#define ATTN_STORE16(p,v) (*(u32x4*)(p)=(v))
#endif
template<int MODE,int THRL,int DV> __device__ __forceinline__ void attn_unit(const bf16*Qp,const bf16*__restrict__ Kc,const bf16*__restrict__ Vc,int ctx_row0,int lat_row0,int NT,bf16*Op,int qrow0,int kr0,const float*rpbh,char*shm){
  int tid_=threadIdx.x; asm volatile("":"+v"(tid_));
  const int tid=tid_,lane=tid&63,r32=lane&31,hi=lane>>5; const int wid=__builtin_amdgcn_readfirstlane(tid>>6);
  const bf16*Qw=Qp+(long)(wid*QBLK)*PY;
  const lds_cptr shm3=(lds_cptr)shm;
  const unsigned lds0=(unsigned)(uintptr_t)shm;
  float*wsf=(float*)(shm+LDS_WS)+wid*64;
  const bf16*ksrc=Kc+(long)lane*PY+wid*8;
  const bf16*vsrc=Vc+(long)(16*(wid&3)+(lane>>2))*PY+(wid>>2)*32+(lane&3)*8;
  const unsigned kdst=lds0+LDS_K+wid*1024, vdst=lds0+LDS_V+wid*1024;
  #define TROW(t) ((t)<4?ctx_row0+64*(t):lat_row0+64*((t)-4))
  #define DMA_K(t,slot) glds16(ksrc+(long)TROW(t)*PY,(unsigned)__builtin_amdgcn_readfirstlane(kdst+(slot)))
  #define DMA_V(t,slot) do{ glds16(vsrc+(long)TROW(t)*PY,(unsigned)__builtin_amdgcn_readfirstlane(vdst+2*(slot))); \
      if(DV==128) glds16(vsrc+64+(long)TROW(t)*PY,(unsigned)__builtin_amdgcn_readfirstlane(vdst+2*(slot)+8192)); }while(0)
  const int vb0=(int)(lds0+LDS_V)+((lane>>4)&1)*32+(lane&3)*8+(4*hi+((lane&15)>>2))*64;
  const char*Kbase=shm+LDS_K; bf16x8 kf[8];
  const lds_cptr kp0=shm3+LDS_K+hi*1024+r32*16; const lds_cptr vp0=shm3+LDS_V+((lane>>4)&1)*32+(lane&3)*8+(4*hi+((lane&15)>>2))*64;
  DMA_K(0,0);DMA_V(0,0);DMA_K(1,SLOTB);
  bf16x8 qr[4];
  #pragma unroll
  for(int d0=0;d0<4;++d0)qr[d0]=*reinterpret_cast<const bf16x8*>(&Qw[(long)r32*PY+d0*16+hi*8]);
  float z0_=0.f; asm volatile("":"+v"(z0_)); f32x16 zv_;
  #pragma unroll
  for(int r=0;r<16;++r)zv_[r]=z0_;
  float mhat=0.f,l_reg=0.f;constexpr int ND=DV/32; f32x16 o[ND];
  #pragma unroll
  for(int d_=0;d_<ND;++d_)o[d_]=zv_;
  f32x16 negm=zv_;asm volatile("":"+v"(negm));
  if(MODE==1){ __attribute__((address_space(3))) float*tabw=(__attribute__((address_space(3))) float*)(shm3+LDS_RPB)+RPB_PAD; for(int i_=tid;i_<465;i_+=NW*64)tabw[i_]=rpbh[i_]*1.4426950408889634f; }
  #define CMASK(P0,P1,t) do{ if(MODE==1){ if((t)>=4){ int t2_=threadIdx.x; asm volatile("":"+v"(t2_)); const int w2_=__builtin_amdgcn_readfirstlane(t2_>>6), r2_=t2_&31, h2_=(t2_>>5)&1; \
      const int na_qr=qrow0+(w2_>>1), na_qc=32*(w2_&1)+r2_, na_rs=min(max(na_qr-4,0),24), na_cs=min(max(na_qc-8,0),48); const int kr_=kr0+(t)-4; \
      namask(P0,P1,(unsigned)(kr_-na_rs)<8u,4*h2_-na_cs,(lds_cfptr)(shm3+LDS_RPB)+RPB_PAD+15-na_qc+4*h2_+(kr_-na_qr+7)*31); } } }while(0)
  bool resc=false;
  #define START(P0,P1) do{ const float rm=rowmax(P0,P1); resc=false; \
    { const float dl=rm; mhat=fadd_s(mhat,dl); \
      _Pragma("unroll") for(int r=0;r<16;++r){P0[r]=fsub_s(P0[r],dl);P1[r]=fsub_s(P1[r],dl);} \
      _Pragma("unroll") for(int r=0;r<16;++r)negm[r]=-mhat; asm volatile("":"+v"(negm)); } \
    _Pragma("unroll") for(int r=0;r<16;++r)P0[r]=__builtin_amdgcn_exp2f(P0[r]); }while(0)
  #define RESC() do{ if(resc){ asm volatile("s_waitcnt lgkmcnt(0)":::"memory"); \
      _Pragma("unroll") for(int d_=0;d_<ND;++d_) _Pragma("unroll") for(int r=0;r<16;++r)o[d_][r]*=wsf[crow(r,hi)]; } }while(0)
  f32x16 pA0,pA1,pB0,pB1;
  int sl_prev=0,sl_cur=0,sl_next=SLOTB;
  #define ROT() do{sl_prev=sl_cur;sl_cur=sl_next;sl_next=(sl_next==(NSLOT-1)*SLOTB)?0:sl_next+SLOTB;}while(0)
  DMA_K(2,2*SLOTB);
  WAIT_BAR(3);
  qkt(pA0,pA1,Kbase,qr,negm,r32,hi);asm volatile("s_nop 15\n\ts_nop 7":"+v"(pA0),"+v"(pA1));CMASK(pA0,pA1,0);
  START(pA0,pA1);
  _Pragma("unroll") for(int r=0;r<16;++r)pA1[r]=__builtin_amdgcn_exp2f(pA1[r]);
  WAIT_BAR(0);
  DMA_K(3,0);DMA_V(1,SLOTB);
  ROT();
  kload8(kf,kp0+sl_cur);
  #define WAIT_KV() do{ if(DV==128){WAIT_BAR(3);}else{WAIT_BAR(2);} }while(0)
  #define WAIT_V() do{ if(DV==128){WAIT_BAR(2);}else{WAIT_BAR(1);} }while(0)
  WAIT_KV();
  s16x4 vlo[8],vhi[8]; u32x4 pw0,pw1,pw2,pw3;
  #define PKW(P,B) cvtpk_s(P[B],P[B+1])
  #define PAF(k) __builtin_bit_cast(bf16x8,pw##k)
  #define VFR(i) (bf16x8){vlo[i][0],vlo[i][1],vlo[i][2],vlo[i][3],vhi[i][0],vhi[i][1],vhi[i][2],vhi[i][3]}
  #define PIN(x) asm volatile("":"+v"(x))
  #define MX3(a,b,c) __builtin_fmaxf(__builtin_fmaxf((a),(b)),(c))
  #define GAPA(MF,A0,A1,A2,A3,W0,W1,PW) do{ MF; sacc+=A0; sacc+=A1; sacc+=A2; sacc+=A3; PIN(sacc); W0; W1; PIN(PW); SBAR(); }while(0)
  #define EX(v) __builtin_amdgcn_exp2f(v)
  #define GAPB(MF,X,B) do{ MF; X[B]=EX(X[B]); X[B+1]=EX(X[B+1]); X[B+2]=EX(X[B+2]); X[B+3]=EX(X[B+3]); PIN(X); SBAR(); }while(0)
  #define VRD(i) do{ vlo[i]=vtr(vp_+(((i)>>2)*4096+((i)&3)*1024)); vhi[i]=vtr(vp_+(((i)>>2)*4096+((i)&3)*1024+512)); }while(0)
  #define VRD2(i) do{ vlo[i]=vtr(vp_+(8192+((i)>>2)*4096+((i)&3)*1024)); vhi[i]=vtr(vp_+(8192+((i)>>2)*4096+((i)&3)*1024+512)); }while(0)
  #define GAPC(MF) do{ MF; SBAR(); }while(0)
  #define KRD(G,j) do{ if(G){ kload2(kf,kp0+sl_next,j); SBAR(); } }while(0)
  #define STEP(C0,C1,P0,P1,t,GK,GV,GL) do{ SBAR(); \
    const lds_cptr vp_=vp0+2*sl_prev; \
    VRD(0); SBAR(); float sacc=(P0[0]+P0[1]); \
    GAPA(C0=__builtin_amdgcn_mfma_f32_32x32x16_bf16(kf[0],qr[0],negm,0,0,0), P0[2],P0[3],P0[4],P0[5],     pw0[0]=PKW(P0,0), pw0[1]=PKW(P0,2), pw0); \
    VRD(4); SBAR(); GAPA(C1=__builtin_amdgcn_mfma_f32_32x32x16_bf16(kf[1],qr[0],negm,0,0,0), P0[6],P0[7],P0[8],P0[9],     pw0[2]=PKW(P0,4), pw0[3]=PKW(P0,6), pw0); \
    VRD(1); SBAR(); GAPA(C0=__builtin_amdgcn_mfma_f32_32x32x16_bf16(kf[2],qr[1],C0,0,0,0),   P0[10],P0[11],P0[12],P0[13], pw1[0]=PKW(P0,8), pw1[1]=PKW(P0,10), pw1); \
    VRD(5); SBAR(); GAPA(C1=__builtin_amdgcn_mfma_f32_32x32x16_bf16(kf[3],qr[1],C1,0,0,0),   P0[14],P0[15],P1[0],P1[1],   pw1[2]=PKW(P0,12),pw1[3]=PKW(P0,14), pw1); \
    VRD(2); SBAR(); GAPA(C0=__builtin_amdgcn_mfma_f32_32x32x16_bf16(kf[4],qr[2],C0,0,0,0),   P1[2],P1[3],P1[4],P1[5],     pw2[0]=PKW(P1,0), pw2[1]=PKW(P1,2), pw2); \
    VRD(6); SBAR(); GAPA(C1=__builtin_amdgcn_mfma_f32_32x32x16_bf16(kf[5],qr[2],C1,0,0,0),   P1[6],P1[7],P1[8],P1[9],     pw2[2]=PKW(P1,4), pw2[3]=PKW(P1,6), pw2); \
    VRD(3); SBAR(); GAPA(C0=__builtin_amdgcn_mfma_f32_32x32x16_bf16(kf[6],qr[3],C0,0,0,0),   P1[10],P1[11],P1[12],P1[13], pw3[0]=PKW(P1,8), pw3[1]=PKW(P1,10), pw3); \
    VRD(7); SBAR(); GAPA(C1=__builtin_amdgcn_mfma_f32_32x32x16_bf16(kf[7],qr[3],C1,0,0,0),   P1[14],P1[15],0.f,0.f,       pw3[2]=PKW(P1,12),pw3[3]=PKW(P1,14), pw3); \
    l_reg+=sacc; \
    if(GK){DMA_K((t)+3,sl_cur);} if(GV){DMA_V((t)+1,sl_next);} \
    CMASK(C0,C1,t); \
    { float a=MX3(C0[0],C0[1],C1[0]),b=MX3(C0[2],C0[3],C1[1]); a=MX3(a,C1[2],C1[3]); \
      _Pragma("unroll") for(int r=4;r<16;r+=4){a=MX3(a,C0[r],C0[r+1]);b=MX3(b,C0[r+2],C0[r+3]);a=MX3(a,C1[r],C1[r+1]);b=MX3(b,C1[r+2],C1[r+3]);} \
      float rm=__builtin_fmaxf(a,b); { auto rr=__builtin_amdgcn_permlane32_swap(__float_as_uint(rm),__float_as_uint(rm),false,false); rm=__builtin_fmaxf(__uint_as_float(rr[0]),__uint_as_float(rr[1])); } \
      resc=false; \
      if(__builtin_expect(__any(rm>(float)THRL),0)){ const float dl=__builtin_fmaxf(rm,0.f); mhat+=dl; \
        _Pragma("unroll") for(int r=0;r<16;++r){C0[r]-=dl;C1[r]-=dl;} \
        _Pragma("unroll") for(int r=0;r<16;++r)negm[r]=-mhat; asm volatile("":"+v"(negm)); \
        const float f=__builtin_amdgcn_exp2f(-dl); l_reg*=f; if(hi==0)wsf[r32]=f; resc=true; } } \
    SBAR(); \
    if constexpr(DV==64){ \
    GAPB(o[0]=__builtin_amdgcn_mfma_f32_32x32x16_bf16(PAF(0),VFR(0),o[0],0,0,0), C0,0); \
    GAPB(o[1]=__builtin_amdgcn_mfma_f32_32x32x16_bf16(PAF(0),VFR(4),o[1],0,0,0), C0,4); \
    KRD(GL,0); GAPB(o[0]=__builtin_amdgcn_mfma_f32_32x32x16_bf16(PAF(1),VFR(1),o[0],0,0,0), C0,8); \
    KRD(GL,1); GAPB(o[1]=__builtin_amdgcn_mfma_f32_32x32x16_bf16(PAF(1),VFR(5),o[1],0,0,0), C0,12); \
    KRD(GL,2); GAPB(o[0]=__builtin_amdgcn_mfma_f32_32x32x16_bf16(PAF(2),VFR(2),o[0],0,0,0), C1,0); \
    KRD(GL,3); GAPB(o[1]=__builtin_amdgcn_mfma_f32_32x32x16_bf16(PAF(2),VFR(6),o[1],0,0,0), C1,4); \
    GAPB(o[0]=__builtin_amdgcn_mfma_f32_32x32x16_bf16(PAF(3),VFR(3),o[0],0,0,0), C1,8); \
    GAPB(o[1]=__builtin_amdgcn_mfma_f32_32x32x16_bf16(PAF(3),VFR(7),o[1],0,0,0), C1,12); \
    } else {   \
    GAPB(o[0]=__builtin_amdgcn_mfma_f32_32x32x16_bf16(PAF(0),VFR(0),o[0],0,0,0), C0,0);  VRD2(0); SBAR(); \
    GAPB(o[1]=__builtin_amdgcn_mfma_f32_32x32x16_bf16(PAF(0),VFR(4),o[1],0,0,0), C0,4);  VRD2(4); SBAR(); \
    GAPB(o[0]=__builtin_amdgcn_mfma_f32_32x32x16_bf16(PAF(1),VFR(1),o[0],0,0,0), C0,8);  VRD2(1); SBAR(); \
    GAPB(o[1]=__builtin_amdgcn_mfma_f32_32x32x16_bf16(PAF(1),VFR(5),o[1],0,0,0), C0,12); VRD2(5); SBAR(); \
    GAPB(o[0]=__builtin_amdgcn_mfma_f32_32x32x16_bf16(PAF(2),VFR(2),o[0],0,0,0), C1,0);  VRD2(2); SBAR(); \
    GAPB(o[1]=__builtin_amdgcn_mfma_f32_32x32x16_bf16(PAF(2),VFR(6),o[1],0,0,0), C1,4);  VRD2(6); SBAR(); \
    GAPB(o[0]=__builtin_amdgcn_mfma_f32_32x32x16_bf16(PAF(3),VFR(3),o[0],0,0,0), C1,8);  VRD2(3); SBAR(); \
    GAPB(o[1]=__builtin_amdgcn_mfma_f32_32x32x16_bf16(PAF(3),VFR(7),o[1],0,0,0), C1,12); VRD2(7); SBAR(); \
    KRD(GL,0); GAPC(o[ND-2]=__builtin_amdgcn_mfma_f32_32x32x16_bf16(PAF(0),VFR(0),o[ND-2],0,0,0)); \
    KRD(GL,1); GAPC(o[ND-1]=__builtin_amdgcn_mfma_f32_32x32x16_bf16(PAF(0),VFR(4),o[ND-1],0,0,0)); \
    KRD(GL,2); GAPC(o[ND-2]=__builtin_amdgcn_mfma_f32_32x32x16_bf16(PAF(1),VFR(1),o[ND-2],0,0,0)); \
    KRD(GL,3); GAPC(o[ND-1]=__builtin_amdgcn_mfma_f32_32x32x16_bf16(PAF(1),VFR(5),o[ND-1],0,0,0)); \
    GAPC(o[ND-2]=__builtin_amdgcn_mfma_f32_32x32x16_bf16(PAF(2),VFR(2),o[ND-2],0,0,0)); \
    GAPC(o[ND-1]=__builtin_amdgcn_mfma_f32_32x32x16_bf16(PAF(2),VFR(6),o[ND-1],0,0,0)); \
    GAPC(o[ND-2]=__builtin_amdgcn_mfma_f32_32x32x16_bf16(PAF(3),VFR(3),o[ND-2],0,0,0)); \
    GAPC(o[ND-1]=__builtin_amdgcn_mfma_f32_32x32x16_bf16(PAF(3),VFR(7),o[ND-1],0,0,0)); \
    } \
    }while(0)
  int t=1;
  for(;t+5<NT;t+=2){
    STEP(pB0,pB1,pA0,pA1,t,true,true,true);     WAIT_KV(); RESC(); ROT();
    STEP(pA0,pA1,pB0,pB1,t+1,true,true,true);   WAIT_KV(); RESC(); ROT();
  }
  #define ENDW(tt) do{ if((tt)+3<NT){WAIT_KV();} else if((tt)+2<NT){WAIT_V();} else {WAIT_BAR(0);} }while(0)
  for(;t+1<NT;t+=2){
    STEP(pB0,pB1,pA0,pA1,t,(t+3<NT),(t+1<NT),(t+1<NT));       ENDW(t);   RESC(); ROT();
    STEP(pA0,pA1,pB0,pB1,t+1,(t+4<NT),(t+2<NT),(t+2<NT));     ENDW(t+1); RESC(); ROT();
  }
  STEP(pB0,pB1,pA0,pA1,NT-1,false,false,false); RESC();
  { float sacc=pB0[0]+pB0[1]; _Pragma("unroll") for(int r=2;r<16;++r)sacc+=pB0[r]; _Pragma("unroll") for(int r=0;r<16;++r)sacc+=pB1[r]; l_reg+=sacc;
    pw0=(u32x4){PKW(pB0,0),PKW(pB0,2),PKW(pB0,4),PKW(pB0,6)};pw1=(u32x4){PKW(pB0,8),PKW(pB0,10),PKW(pB0,12),PKW(pB0,14)};pw2=(u32x4){PKW(pB1,0),PKW(pB1,2),PKW(pB1,4),PKW(pB1,6)};pw3=(u32x4){PKW(pB1,8),PKW(pB1,10),PKW(pB1,12),PKW(pB1,14)};
    SBAR(); pv<ND>(o,vb0+2*sl_cur,PAF(0),PAF(1),PAF(2),PAF(3)); }
  #undef PKW
  #undef PAF
  #undef VFR
  #undef PIN
  #undef MX3
  #undef GAPA
  #undef GAPB
  #undef EX
  #undef VRD
  #undef KRD
  #undef VRD2
  #undef GAPC
  #undef WAIT_KV
  #undef WAIT_V
  #undef STEP
  #undef ENDW
  {auto rr=__builtin_amdgcn_permlane32_swap(__float_as_uint(l_reg),__float_as_uint(l_reg),false,false);l_reg=__uint_as_float(rr[0])+__uint_as_float(rr[1]);}
  if(hi==0)wsf[32+r32]=l_reg;asm volatile("s_waitcnt lgkmcnt(0)":::"memory");
  float rli[16];
  #pragma unroll
  for(int r=0;r<16;++r)rli[r]=__builtin_amdgcn_rcpf(wsf[32+crow(r,hi)]);
  bf16*Ow=Op+(long)(wid*QBLK)*PO;
  { bf16*stg=(bf16*)(shm+LDS_OST)+wid*2048;
    #pragma unroll
    for(int hf=0;hf<ND/2;++hf){
      #pragma unroll
      for(int r=0;r<16;++r){const int orow=crow(r,hi);
        #pragma unroll
        for(int d0=0;d0<2;++d0)stg[orow*64+d0*32+r32]=__float2bfloat16(o[2*hf+d0][r]*rli[r]);}
      asm volatile("s_waitcnt lgkmcnt(0)":::"memory");
      #pragma unroll
      for(int i=0;i<4;++i){const int row=i*8+(lane>>3),ch=lane&7; const u32x4 v=*(const u32x4*)(stg+row*64+ch*8); ATTN_STORE16(Ow+(long)row*PO+hf*64+ch*8,v);}
      asm volatile("s_waitcnt lgkmcnt(0)":::"memory");
    } }
  asm volatile("s_waitcnt lgkmcnt(0)\n\ts_barrier":::"memory");
  #undef TROW
  #undef DMA_K
  #undef DMA_V
  #undef CMASK
  #undef START
  #undef RESC
  #undef ROT
}
constexpr int ATTN_LDS_BYTES=LDS_BYTES;
#undef SBAR
#undef WAIT_BAR
}

#define GAS __attribute__((address_space(1)))
#define LAS __attribute__((address_space(3)))
typedef unsigned v4u __attribute__((ext_vector_type(4)));
typedef float f32x4 __attribute__((ext_vector_type(4)));
typedef short bf16x8 __attribute__((ext_vector_type(8)));
typedef GAS unsigned gu32;
typedef GAS unsigned long long gu64;
#define RLX_AGENT __ATOMIC_RELAXED, __HIP_MEMORY_SCOPE_AGENT
#define LDS_WAIT() asm volatile("s_waitcnt lgkmcnt(0)" ::: "memory")
#define VM_WAIT() asm volatile("s_waitcnt vmcnt(0)" ::: "memory")
__device__ __forceinline__ unsigned long long rt() { return __builtin_amdgcn_s_memrealtime(); }
__device__ __forceinline__ unsigned pk2(float lo, float hi) { return (unsigned)f2bf(lo) | ((unsigned)f2bf(hi) << 16); }

#define XB_TMO      128
#define XB_XCNT(j)  (256  + 64 * (j))
#define XB_XSUB(j)  (1280 + 64 * (j))
#define XB_XGEN(j)  (2304 + 64 * (j))
#define XB_TOP      3328
#define XB_TOPGEN   3392
#define XCD_BAR_WORDS 3456
#define XB_SPIN_CAP (1u << 18)

__device__ __forceinline__ unsigned xb_ld(unsigned* p)              { return __hip_atomic_load(p, __ATOMIC_RELAXED, __HIP_MEMORY_SCOPE_AGENT); }
__device__ __forceinline__ unsigned xb_add(unsigned* p, unsigned v) { return __hip_atomic_fetch_add(p, v, __ATOMIC_RELAXED, __HIP_MEMORY_SCOPE_AGENT); }
__device__ __forceinline__ unsigned xb_xcc_id() { return (unsigned)__builtin_amdgcn_s_getreg((3 << 11) | 20) & 0xFu; }
#define XB_SPIN(cond, bar) do { unsigned _sp = 0; while (cond) { __builtin_amdgcn_s_sleep(1); \
    if ((++_sp & 255u) == 0u) { if (xb_ld(&(bar)[XB_TMO])) break; if (_sp > XB_SPIN_CAP) { atomicAdd(&(bar)[XB_TMO], 1u); break; } } } } while (0)

struct XcdBarrier {
    unsigned* bar; unsigned x;
    volatile LAS unsigned* st;
};

__device__ __forceinline__ XcdBarrier xcd_barrier_post(unsigned* bar, volatile LAS unsigned* st) {
    XcdBarrier b; b.bar = bar; b.x = xb_xcc_id(); b.st = st;
    if (threadIdx.x == 0) (void)xb_add(&bar[XB_XCNT(b.x)], 1u);
    return b;
}
__device__ __forceinline__ void xcd_barrier_complete(unsigned* bar, unsigned x, unsigned& nloc, unsigned& nx) {
    const unsigned G = gridDim.x * gridDim.y * gridDim.z;
    unsigned sum, cnt, mine, sp = 0u;
    for (;;) {
        sum = 0u; cnt = 0u; mine = 0u;
#pragma unroll
        for (unsigned j = 0; j < 16; ++j) { const unsigned c = xb_ld(&bar[XB_XCNT(j)]); sum += c; cnt += (c > 0u) ? 1u : 0u; mine = (j == x) ? c : mine; }
        if (sum == G) break;
        __builtin_amdgcn_s_sleep(1);
        if ((++sp & 255u) == 0u) { if (xb_ld(&bar[XB_TMO])) break; if (sp > XB_SPIN_CAP) { atomicAdd(&bar[XB_TMO], 1u); break; } }
    }
    nloc = mine > 0u ? mine : 1u; nx = cnt > 0u ? cnt : 1u;
}

__device__ __forceinline__ void xcd_barrier(const XcdBarrier& b) {
    asm volatile("s_waitcnt vmcnt(0)" ::: "memory");
    __syncthreads();
    if (threadIdx.x == 0) {
        unsigned* bar = b.bar;
        __builtin_amdgcn_s_waitcnt(0);
        unsigned nloc = b.st[0], nx = b.st[1];
        if (nloc == 0u) { xcd_barrier_complete(bar, b.x, nloc, nx); b.st[0] = nloc; b.st[1] = nx; }
        const unsigned old = xb_add(&bar[XB_XSUB(b.x)], 1u);
        const unsigned gen = old / nloc;
        if (old + 1u == (gen + 1u) * nloc) {
            __builtin_amdgcn_fence(__ATOMIC_RELEASE, "agent");
            asm volatile("s_waitcnt vmcnt(0)" ::: "memory");
            const unsigned og = xb_add(&bar[XB_TOP], 1u);
            const unsigned tg = og / nx;
            if (og + 1u == (tg + 1u) * nx) xb_add(&bar[XB_TOPGEN], 1u);
            else XB_SPIN(xb_ld(&bar[XB_TOPGEN]) == tg, bar);
            __builtin_amdgcn_fence(__ATOMIC_ACQUIRE, "agent");
            xb_add(&bar[XB_XGEN(b.x)], 1u);
            asm volatile("s_waitcnt vmcnt(0)" ::: "memory");
        } else {
            XB_SPIN(xb_ld(&bar[XB_XGEN(b.x)]) == gen, bar);
            __builtin_amdgcn_fence(__ATOMIC_ACQUIRE, "agent");
            asm volatile("s_waitcnt vmcnt(0)" ::: "memory");
        }
    }
    __syncthreads();
}

constexpr int NWAVES = 8;
constexpr int N_PHASES = 12;
constexpr int CW_BAR = 4096;
static_assert((CW_BAR + 4 * XCD_BAR_WORDS) * 4 <= (int)CTL_ZERO_BYTES, "CTL words inside the memset region");
constexpr int RING_OFF = 0, RING_BYTES = 131072;
constexpr int LDSCTL_OFF = RING_BYTES, MISC_OFF = LDSCTL_OFF + 320;
constexpr int TAB_OFF = RING_BYTES + 1024, TAB_FLOATS = 2048 + 256;
constexpr int LDS_BYTES = 147456;
static_assert(MISC_OFF + 128 <= TAB_OFF && TAB_OFF + TAB_FLOATS * 4 <= LDS_BYTES, "LDS map");

struct Args { const float* in[25]; float* out; unsigned char* ws; int ph_lo, ph_hi, li, flags; };
struct Frame {
    LAS unsigned char* lds; volatile LAS unsigned* MISC; gu32* ctl;
    int tid, lane, wave, vcu, G;
};

__device__ __forceinline__ float wave_sum(float v) {
#pragma unroll
    for (int o = 1; o < 64; o <<= 1) v += __shfl_xor(v, o);
    return v;
}
__device__ __forceinline__ void wsrc_block(int kind, int nb, int& src0, int& perm, int& gap) {
    gap = 0;
    if (kind == 0) { src0 = 32 * nb; perm = 0; }
    else if (kind == 1) { const int tile = nb >> 3, l = nb & 7, bj = l >> 2, wc = l & 3; src0 = bj * FF + 128 * tile + 32 * wc; perm = 1; }
    else { const int tile = nb >> 3, l = nb & 7, grp = tile >> 1; if (grp == 2 || grp == 5) { src0 = 32 * nb; perm = 1; }
           else { const int bj = l >> 2, wc = l & 3; src0 = 256 * tile + 64 * wc + 16 * bj; perm = 2; gap = 16; } }
}
__device__ __forceinline__ void p0_transpose_item(const float* W, int K, int N, bf16_t* WT, int kind, LAS float* scr, int item, int lane) {
    const int nblk = N / 32, kb = item / nblk, nb = item % nblk, k0 = 64 * kb; int src0, perm, gap; wsrc_block(kind, nb, src0, perm, gap);
    const int scol = src0 + (lane & 31) + ((lane & 16) ? gap : 0);
#pragma unroll 8
    for (int i = 0; i < 32; ++i) { const int kk = 2 * i + (lane >> 5); scr[kk * 33 + (lane & 31)] = W[(size_t)(k0 + kk) * N + scol]; }
    LDS_WAIT(); asm volatile("" ::: "memory");
    const int c = lane & 7;
#pragma unroll
    for (int j = 0; j < 4; ++j) { const int n = (lane >> 3) + 8 * j;
        const int sn = perm == 1 ? pg8::perm32(n) : perm == 2 ? (16 * ((n >> 3) & 1) + 8 * ((n >> 2) & 1) + 4 * (n >> 4) + (n & 3)) : n; const LAS float* s = scr + (8 * c) * 33 + sn;
        v4u o; o.x = pk2(s[0 * 33], s[1 * 33]); o.y = pk2(s[2 * 33], s[3 * 33]); o.z = pk2(s[4 * 33], s[5 * 33]); o.w = pk2(s[6 * 33], s[7 * 33]);
        *(GAS v4u*)(WT + (size_t)(32 * nb + n) * K + k0 + 8 * c) = o; }
    LDS_WAIT(); asm volatile("" ::: "memory");
}
__device__ __forceinline__ void weight_copies(Frame& F, const Args& a, int part, int gw, int NGW) {
    unsigned char* ws = a.ws;
    LAS float* scr = (LAS float*)(F.lds + RING_OFF + F.wave * 16384);
    constexpr int I_GU = (D / 64) * (2 * FF / 32), I_D = (FF / 64) * (D / 32), I_IN = (D / 64) * (NIN / 32), I_OUT = (D / 64) * (D / 32);
    if (part == 0) {
        for (int it = gw; it < I_GU; it += NGW) p0_transpose_item(a.in[9], D, 2 * FF, (bf16_t*)(ws + WS_WGU1), 1, scr, it, F.lane);
    } else if (part == 2) {
        for (int it = gw; it < I_D; it += NGW) p0_transpose_item(a.in[10], FF, D, (bf16_t*)(ws + WS_WD1), 0, scr, it, F.lane);
    } else {
        for (int it = gw; it < I_GU + I_D + I_IN + I_OUT; it += NGW) {
            int r = it;
            if (r < I_IN) { p0_transpose_item(a.in[11], D, NIN, (bf16_t*)(ws + WS_WIN), 2, scr, r, F.lane); continue; } r -= I_IN;
            if (r < I_OUT) { p0_transpose_item(a.in[22], D, D, (bf16_t*)(ws + WS_WOUT), 0, scr, r, F.lane); continue; } r -= I_OUT;
            if (r < I_GU) { p0_transpose_item(a.in[23], D, 2 * FF, (bf16_t*)(ws + WS_WGU2), 1, scr, r, F.lane); continue; } r -= I_GU;
            p0_transpose_item(a.in[24], FF, D, (bf16_t*)(ws + WS_WD2), 0, scr, r, F.lane);
        }
    }
}
__device__ __forceinline__ void adaln_units(Frame& F, const Args& a, int j0, int j1, int gi, int gn) {
    float* mod = (float*)(a.ws + WS_MOD);
    LAS float* s = (LAS float*)(F.lds + RING_OFF);
    LAS float* part = (LAS float*)(F.lds + RING_OFF + 9 * D * 4);
    const float* c = a.in[1]; const float* c_ctx = a.in[3]; const float* w_ada = a.in[4]; const float* b_ada = a.in[5];
    __syncthreads();
    for (int idx = F.tid; idx < 9 * D; idx += NWAVES * 64) { const int r = idx >> 10, k = idx & (D - 1); const float v = r < NB ? c[r * D + k] : c_ctx[k]; s[idx] = v / (1.f + __expf(-v)); }
    __syncthreads();
    for (int j = j0 + gi; j < j1; j += gn) {
        const int cg = F.tid & 7, ks = F.tid >> 3;
        f32x4 acc[9];
#pragma unroll
        for (int r = 0; r < 9; ++r) acc[r] = (f32x4){0.f, 0.f, 0.f, 0.f};
#pragma unroll 4
        for (int kk = 0; kk < 16; ++kk) { const int k = ks * 16 + kk; const f32x4 w = *(const f32x4*)(w_ada + (size_t)k * (NMOD * D) + 32 * j + 4 * cg);
#pragma unroll
            for (int r = 0; r < 9; ++r) acc[r] += w * s[r * D + k]; }
#pragma unroll
        for (int r = 0; r < 9; ++r) *(LAS f32x4*)(part + (ks * 9 + r) * 32 + 4 * cg) = acc[r];
        __syncthreads();
        if (F.tid < 288) { const int r = F.tid >> 5, col = F.tid & 31; float sum = 0.f;
#pragma unroll 8
            for (int q = 0; q < 64; ++q) sum += part[(q * 9 + r) * 32 + col];
            mod[r * (NMOD * D) + 32 * j + col] = sum + b_ada[32 * j + col]; }
        __syncthreads();
    }
}
constexpr int ADA_EARLY = 2 * D / 32;
__device__ __forceinline__ void p0_prologue(Frame& F, const Args& a) {
    unsigned char* ws = a.ws;
    float* misc = (float*)(ws + WS_MISC);
    adaln_units(F, a, 0, ADA_EARLY, F.vcu, F.G);
    if (F.vcu == 0) {
        for (int e = F.tid; e < 1024; e += NWAVES * 64) { const int pos = e >> 4, i = e & 15; const float ang = (float)pos * powf(10000.f, -(float)i / 16.f); misc[e] = cosf(ang); misc[1024 + e] = sinf(ang); }
        if (F.tid < 64) { misc[2112 + F.tid] = a.in[12][F.tid]; misc[2176 + F.tid] = a.in[13][F.tid]; misc[2240 + F.tid] = a.in[19][F.tid]; misc[2304 + F.tid] = a.in[20][F.tid]; }
        if (F.tid == 0) { float x1 = 0.f, x2 = 0.f; for (int d = 0; d < 64; ++d) { x1 += a.in[14][d] * a.in[15][d]; x2 += a.in[16][d] * a.in[17][d]; } misc[2048] = expf(x1) - expf(x2) + LAM_INIT; }
    }
    __syncthreads();
    weight_copies(F, a, 0, F.vcu * NWAVES + F.wave, F.G * NWAVES);
}
template <int ST  >
__device__ __forceinline__ void normmod_phase(Frame& F, const void* lat, const float* ctx, const float* part  , int nrows, const float* gain, const float* mod, int shift_i, int scale_i, bf16_t* XN) {
    const int gw = F.vcu * NWAVES + F.wave, NGW = F.G * NWAVES, lane = F.lane;
    for (int row = gw; row < nrows; row += NGW) {
        const bool isl = row < ML; const int b = isl ? row / SEQ : NB;
        const float* sh = mod + b * (NMOD * D) + shift_i * D; const float* sc = mod + b * (NMOD * D) + scale_i * D;
        f32x4 v[4]; float ss = 0.f;
#pragma unroll
        for (int j = 0; j < 4; ++j) {
            if (!isl) { const size_t o2 = (size_t)(row - ML) * D + j * 256 + lane * 4; v[j] = *(const f32x4*)(ctx + o2);
                if (part) v[j] += (*(const f32x4*)(part + o2) + *(const f32x4*)(part + (size_t)MC * D + o2)) * (*(const f32x4*)(mod + NB * (NMOD * D) + 2 * D + j * 256 + lane * 4) * 0.5f); }
            else if (ST == 0) v[j] = *(const f32x4*)((const float*)lat + (size_t)row * D + j * 256 + lane * 4);
            else v[j] = __builtin_convertvector(*(const pg8::f16x4*)((const _Float16*)lat + (size_t)row * D + j * 256 + lane * 4), f32x4);
            const f32x4 q = v[j] * v[j]; ss += (q[0] + q[1]) + (q[2] + q[3]); }
        const float rstd = rsqrtf(wave_sum(ss) * (1.f / D) + EPS);
#pragma unroll
        for (int j = 0; j < 4; ++j) {
            const int col = j * 256 + lane * 4;
            const f32x4 g = *(const f32x4*)(gain + col), s4 = *(const f32x4*)(sh + col), c4 = *(const f32x4*)(sc + col);
            const f32x4 o = v[j] * rstd * g * (c4 + 1.f) + s4;
            unsigned long long w = (unsigned long long)pk2(o[0], o[1]) | ((unsigned long long)pk2(o[2], o[3]) << 32);
            *(unsigned long long*)(XN + (size_t)row * D + col) = w;
        }
    }
}
__device__ __forceinline__ void combine_phase(Frame& F, const bf16_t* OD, const float* gain, const float* misc, bf16_t* AO) {
    const int gw = F.vcu * NWAVES + F.wave, NGW = F.G * NWAVES, lane = F.lane; const float lam = misc[2048];
    const float g0 = gain[lane * 2], g1 = gain[lane * 2 + 1];
    for (int w = gw; w < ML * 4; w += NGW) {
        const int row = w >> 2, h = w & 3;
        const unsigned a = *(const unsigned*)(OD + (size_t)row * D + h * 256 + lane * 2), b = *(const unsigned*)(OD + (size_t)row * D + h * 256 + 128 + lane * 2);
        const float d0 = __uint_as_float(a << 16) - lam * __uint_as_float(b << 16), d1 = __uint_as_float(a & 0xffff0000u) - lam * __uint_as_float(b & 0xffff0000u);
        const float rstd = rsqrtf(wave_sum(d0 * d0 + d1 * d1) * (1.f / 128.f) + EPS) * (1.f - LAM_INIT);
        *(unsigned*)(AO + (size_t)row * D + h * 128 + lane * 2) = pk2(d0 * rstd * g0, d1 * rstd * g1);
    }
}
__device__ __forceinline__ void attention_phase(Frame& F, unsigned char* ldsg, const bf16_t* Yb, bf16_t* ODb, bf16_t* AOb, const float* rpb, const float* gain, const float* misc) {
    using attn_body::bf16;
    const bf16* Y = (const bf16*)Yb; bf16* OD = (bf16*)ODb; bf16* AO = (bf16*)AOb;
    for (int ug = F.vcu; ug < 256; ug += F.G) {
        const int b = ug >> 5, h = (ug >> 3) & 3, qb = ug & 7;
        const long qrow = (long)b * SEQ + qb * 256;
        for (int c = 0; c < 2; ++c)
            attn_body::attn_unit<0, 8, 128>(Y + qrow * NIN + h * 128 + c * 64, Y + 512 + h * 128 + c * 64, Y + 1024 + h * 128, ML + b * CTX, b * SEQ, 36,
                                            OD + qrow * D + h * 256 + c * 128, 0, 0, nullptr, (char*)ldsg);
        asm volatile("s_waitcnt vmcnt(0)" ::: "memory"); __syncthreads();
        const float lam = misc[2048]; const int lane = F.lane; const float g0 = gain[lane * 2], g1 = gain[lane * 2 + 1];
        for (int r = 0; r < 32; ++r) {
            const long row = qrow + F.wave * 32 + r;
            const unsigned a = *(const unsigned*)(ODb + row * D + h * 256 + lane * 2), bb = *(const unsigned*)(ODb + row * D + h * 256 + 128 + lane * 2);
            const float d0 = __uint_as_float(a << 16) - lam * __uint_as_float(bb << 16), d1 = __uint_as_float(a & 0xffff0000u) - lam * __uint_as_float(bb & 0xffff0000u);
            const float rstd = rsqrtf(wave_sum(d0 * d0 + d1 * d1) * (1.f / 128.f) + EPS) * (1.f - LAM_INIT);
            *(unsigned*)(AOb + row * D + h * 128 + lane * 2) = pk2(d0 * rstd * g0, d1 * rstd * g1);
        }
    }
    const int ngrp = F.G >> 2, grp0 = F.vcu >> 2, j = F.vcu & 3;
    for (int grp = grp0; grp < 64; grp += ngrp) {
        const int b = grp >> 3, h = grp & 7;
        for (int i = 0; i < 2; ++i) { const int uq = j + 4 * i;
            const int kr0 = (uq == 0) ? 0 : (uq == 7 ? 24 : 4 * uq - 4), nrow = (uq == 0 || uq == 7) ? 8 : 12;
            const long qrow = (long)b * SEQ + uq * 256;
            attn_body::attn_unit<1, 8, 64>(Y + qrow * NIN + 1536 + h * 64, Y + 2048 + h * 64, Y + 2560 + h * 64, ML + b * CTX, b * SEQ + 64 * kr0, 4 + nrow,
                                       AO + qrow * D + 512 + h * 64, 4 * uq, kr0, rpb + h * 465, (char*)ldsg); }
    }
}

__global__ void __launch_bounds__(NWAVES * 64, 2) mk_fwd(Args args) {
    extern __shared__ __attribute__((aligned(16))) unsigned char lds[];
    Frame F;
    F.lds = (LAS unsigned char*)lds;
    F.MISC = (volatile LAS unsigned*)(F.lds + MISC_OFF);
    F.tid = threadIdx.x; F.lane = F.tid & 63; F.wave = __builtin_amdgcn_readfirstlane(F.tid >> 6);
    F.G = gridDim.x; { const int bx = blockIdx.x; F.vcu = (F.G % 8 == 0) ? (bx % 8) * (F.G / 8) + bx / 8 : bx; }
    unsigned char* ws = args.ws;
    F.ctl = (gu32*)(ws + WS_CTL);
    for (int u = F.tid; u < (LDS_BYTES - LDSCTL_OFF) / 4; u += NWAVES * 64) ((LAS unsigned*)(F.lds + LDSCTL_OFF))[u] = 0u;
    __syncthreads();
    XcdBarrier bar = xcd_barrier_post((unsigned*)(F.ctl + CW_BAR) + args.li * XCD_BAR_WORDS, F.MISC + 8);
    const int lo = args.ph_lo, hi = args.ph_hi;
#ifndef PHMASK
#define PHMASK 0xFFF
#endif
#define IN(k) (((PHMASK >> (k)) & 1) && lo <= (k) && (k) < hi)
#ifndef REPMASK
#define REPMASK 0
#endif
#define REP(k) for (int rep_ = 0; rep_ < (((REPMASK >> (k)) & 1) ? 2 : 1); ++rep_)
#ifndef BARX
#define BARX 1
#endif
#define SEAM(k) do { if (IN(k) && IN((k) + 1)) { for (int bx_ = 0; bx_ < BARX; ++bx_) xcd_barrier(bar); } } while (0)
    float* out = args.out;
    float* mod = (float*)(ws + WS_MOD); float* misc = (float*)(ws + WS_MISC);
    bf16_t* XN = (bf16_t*)(ws + WS_XN); bf16_t* AO = XN;
    bf16_t* H = (bf16_t*)(ws + WS_BIG); bf16_t* Y = (bf16_t*)(ws + WS_BIG); bf16_t* OD = (bf16_t*)(ws + WS_OD);
    const float* x = args.in[0]; const float* ctx = args.in[2];
    float* part = (float*)(ws + WS_PART);
    _Float16* h1 = (_Float16*)out;
    _Float16* h2 = (_Float16*)(ws + WS_OD);

    if (IN(0)) REP(0) { p0_prologue(F, args); } SEAM(0);
    if (IN(1)) REP(1) { normmod_phase<0>(F, x, ctx, nullptr, MA, args.in[6], mod, 0, 1, XN); } SEAM(1);
    if (IN(2)) REP(2) { pg8::Gemm g{XN, (const bf16_t*)(ws + WS_WGU1), MA, 2 * FF, D}; pg8::StaticOrder S; S.init(MA, 2 * FF, F.G, (int)blockIdx.x); pg8::EpiGU E{H, pg8::mk_rsrc(H, (size_t)MA * FF * 2)};
        pg8::gemm_phase<pg8::EpiGU, pg8::StaticOrder, true, true>(F.lds + RING_OFF, g, S, E);
        { const int nb = (MA / 256) * (2 * FF / 256) % F.G; const int gi = nb > 0 ? (int)blockIdx.x - nb : F.vcu, gn = nb > 0 ? F.G - nb : F.G;
          if (gi >= 0) { adaln_units(F, args, ADA_EARLY, NMOD * D / 32, gi, gn); __syncthreads(); weight_copies(F, args, 2, gi * NWAVES + F.wave, gn * NWAVES); } } } SEAM(2);
    if (IN(3)) REP(3) { pg8::Gemm g{H, (const bf16_t*)(ws + WS_WD1), MA, D, FF}; pg8::Phase3Order S; S.init(F.G, (int)blockIdx.x); pg8::EpiRes<0, 1> E{x, nullptr, h1, part, mod, 2, 0.5f, pg8::mk_rsrc(part, (size_t)2 * MC * D * 4)};
        pg8::gemm_phase<pg8::EpiRes<0, 1>, pg8::Phase3Order, true, true>(F.lds + RING_OFF, g, S, E);
        { const int nbusy = 320 % F.G; if (nbusy > 0) { if ((int)blockIdx.x >= nbusy) weight_copies(F, args, 1, ((int)blockIdx.x - nbusy) * NWAVES + F.wave, (F.G - nbusy) * NWAVES); }
          else weight_copies(F, args, 1, F.vcu * NWAVES + F.wave, F.G * NWAVES); } } SEAM(3);
    if (IN(4)) REP(4) { normmod_phase<1>(F, h1, ctx, part, MA, args.in[7], mod, 3, 4, XN); } SEAM(4);
    if (IN(5)) REP(5) { pg8::Gemm g{XN, (const bf16_t*)(ws + WS_WIN), MA, NIN, D}; pg8::StaticOrder S; S.init(MA, NIN, F.G, (int)blockIdx.x);
        { LAS float* tab = (LAS float*)(F.lds + TAB_OFF); for (int i = F.tid; i < TAB_FLOATS; i += NWAVES * 64) tab[i] = misc[i < 2048 ? i : 64 + i]; __syncthreads(); }
        pg8::EpiIn E{Y, pg8::mk_rsrc(Y, (size_t)MA * NIN * 2), (const LAS float*)(F.lds + TAB_OFF)};
        pg8::gemm_phase<pg8::EpiIn, pg8::StaticOrder, true, true>(F.lds + RING_OFF, g, S, E); } SEAM(5);
    if (IN(6)) REP(6) { attention_phase(F, lds + RING_OFF, Y, OD, AO, args.in[21], args.in[18], misc); }
    if (IN(6) && (IN(7) || IN(8))) xcd_barrier(bar);
    if (IN(8)) REP(8) { pg8::Gemm g{AO, (const bf16_t*)(ws + WS_WOUT), ML, D, D}; pg8::StaticOrder S; S.init(ML, D, F.G, (int)blockIdx.x); pg8::EpiRes<1, 1> E{h1, nullptr, h2, nullptr, mod, 5, 1.f, pg8::mk_rsrc(part, 16)};
        pg8::gemm_phase<pg8::EpiRes<1, 1>, pg8::StaticOrder, true, true>(F.lds + RING_OFF, g, S, E); } SEAM(8);
    if (IN(9)) REP(9) { normmod_phase<1>(F, h2, ctx, nullptr, ML, args.in[8], mod, 6, 7, XN); } SEAM(9);
    if (IN(10)) REP(10) { pg8::Gemm g{XN, (const bf16_t*)(ws + WS_WGU2), ML, 2 * FF, D}; pg8::StaticOrder S; S.init(ML, 2 * FF, F.G, (int)blockIdx.x); pg8::EpiGU E{H, pg8::mk_rsrc(H, (size_t)ML * FF * 2)};
        pg8::gemm_phase<pg8::EpiGU, pg8::StaticOrder, true, true>(F.lds + RING_OFF, g, S, E); } SEAM(10);
    if (IN(11)) REP(11) { pg8::Gemm g{H, (const bf16_t*)(ws + WS_WD2), ML, D, FF}; pg8::StaticOrder S; S.init(ML, D, F.G, (int)blockIdx.x); pg8::EpiRes<1, 0> E{h2, nullptr, out, nullptr, mod, 8, 0.5f, pg8::mk_rsrc(part, 16)};
        pg8::gemm_phase<pg8::EpiRes<1, 0>, pg8::StaticOrder, true, true>(F.lds + RING_OFF, g, S, E); }
#undef IN
#undef SEAM
}

extern "C" void kernel_launch(void* const* d_in, const int* in_sizes, int n_in, void* d_out, int out_size, void* d_ws, size_t ws_size, hipStream_t stream) {
    static int grid = 0;
    if (grid == 0) {
        if (n_in != 25 || out_size != ML * D || ws_size < WS_END) { fprintf(stderr, "kernel_launch: unexpected shapes n_in %d out %d ws %zu\n", n_in, out_size, ws_size); grid = -1; return; }
        int dev = 0, cus = 0, per_cu = 0;
        if (hipGetDevice(&dev) != hipSuccess || hipDeviceGetAttribute(&cus, hipDeviceAttributeMultiprocessorCount, dev) != hipSuccess) { grid = -1; return; }
        if (hipFuncSetAttribute((const void*)mk_fwd, hipFuncAttributeMaxDynamicSharedMemorySize, LDS_BYTES) != hipSuccess) { fprintf(stderr, "kernel_launch: hipFuncSetAttribute failed\n"); grid = -1; return; }
        if (hipOccupancyMaxActiveBlocksPerMultiprocessor(&per_cu, (const void*)mk_fwd, NWAVES * 64, LDS_BYTES) != hipSuccess || per_cu < 1) { fprintf(stderr, "kernel_launch: occupancy query says %d blocks per CU\n", per_cu); (void)hipGetLastError(); grid = -1; return; }
        grid = cus;
    }
    if (grid < 0) return;
    (void)hipMemsetAsync((unsigned char*)d_ws + WS_CTL, 0, CTL_ZERO_BYTES, stream);
    Args a{};
    for (int i = 0; i < 25; ++i) a.in[i] = (const float*)d_in[i];
    a.out = (float*)d_out; a.ws = (unsigned char*)d_ws; a.ph_lo = 0; a.ph_hi = N_PHASES; a.li = 0; a.flags = 0;
#ifndef PROBE_PHASE
#define PROBE_PHASE -1
#endif
    if (PROBE_PHASE < 0) hipLaunchKernelGGL(mk_fwd, dim3(grid), dim3(NWAVES * 64), LDS_BYTES, stream, a);
    else {
        a.ph_lo = 0; a.ph_hi = PROBE_PHASE + 1; a.li = 0; hipLaunchKernelGGL(mk_fwd, dim3(grid), dim3(NWAVES * 64), LDS_BYTES, stream, a);
        a.ph_lo = PROBE_PHASE; a.ph_hi = PROBE_PHASE + 1; a.li = 1; hipLaunchKernelGGL(mk_fwd, dim3(grid), dim3(NWAVES * 64), LDS_BYTES, stream, a);
        if (PROBE_PHASE + 1 < N_PHASES) { a.ph_lo = PROBE_PHASE + 1; a.ph_hi = N_PHASES; a.li = 2; hipLaunchKernelGGL(mk_fwd, dim3(grid), dim3(NWAVES * 64), LDS_BYTES, stream, a); }
    }
}
```
